# Optimizing an MI355X kernel written in HIP

```python
import math
import jax, jax.numpy as jnp
from jax import lax
import numpy as np

D_MODEL = 2048
BATCH = 4
SEQ = 2048
DEPTH = 1
DEC_BATCH = 128
DEC_SEQ = 1
PAST_LEN = 16384
PAGE_SIZE = 128

N_META = 16
MIX_WIDTH = D_MODEL
GDN_HEADS = 8
GDN_HEAD_K = 128
GDN_HEAD_V = 128
GDN_WIDTH = GDN_HEADS * GDN_HEAD_V
CONF_WIDTH = MIX_WIDTH - GDN_WIDTH
SHORT_CONV = 4
CONF_KERNEL = 31
GDN_CHUNK = 64
QKV_WIDTH = 2 * GDN_HEADS * GDN_HEAD_K + GDN_WIDTH
IN_COLS = QKV_WIDTH + 2 * GDN_HEADS + GDN_WIDTH + 3 * CONF_WIDTH
RMS_EPS = 1e-6
LN_EPS = 1e-5

kernel_name = "hymba_gdn_conformer_step"


def _rmsnorm(x, w):
    xf = x.astype(jnp.float32)
    y = xf * lax.rsqrt(jnp.mean(xf * xf, axis=-1, keepdims=True) + RMS_EPS)
    return (y * w.astype(jnp.float32)).astype(x.dtype)


def _l2norm(x):
    return x * lax.rsqrt(jnp.sum(x * x, axis=-1, keepdims=True) + RMS_EPS)


def _causal_dwconv(x, hist, w):
    xp = jnp.concatenate([hist.astype(x.dtype), x], axis=1)
    y = lax.conv_general_dilated(xp, w.astype(x.dtype)[:, None, :], (1,), 'VALID',
                                 dimension_numbers=('NWC', 'WIO', 'NWC'),
                                 feature_group_count=x.shape[-1])
    return y, xp[:, xp.shape[1] - (w.shape[0] - 1):]


def _gdn_chunk(S, inp):
    q, k, v, g, beta = inp
    C = q.shape[-2]
    gcum = jnp.cumsum(g, axis=-1)
    idx = jnp.arange(C)
    incl = idx[:, None] >= idx[None, :]
    strict = idx[:, None] > idx[None, :]
    diff = gcum[..., :, None] - gcum[..., None, :]
    gam = jnp.where(incl, jnp.exp(jnp.where(incl, diff, 0.0)), 0.0)
    a = jnp.where(strict, beta[..., :, None] * jnp.einsum('bhik,bhjk->bhij', k, k) * gam, 0.0)
    eye = jnp.eye(C, dtype=jnp.float32)
    rhs = jnp.concatenate([beta[..., None] * v, (beta * jnp.exp(gcum))[..., None] * k], axis=-1)
    sol = lax.linalg.triangular_solve(a + eye, rhs, left_side=True, lower=True, unit_diagonal=True)
    u, wk = sol[..., :GDN_HEAD_V], sol[..., GDN_HEAD_V:]
    v_new = u - jnp.einsum('bhck,bhkv->bhcv', wk, S)
    o = (jnp.exp(gcum)[..., None] * jnp.einsum('bhck,bhkv->bhcv', q, S)
         + jnp.einsum('bhij,bhjv->bhiv', jnp.einsum('bhik,bhjk->bhij', q, k) * gam, v_new))
    g_last = gcum[..., -1:]
    S_new = (jnp.exp(g_last)[..., None] * S
             + jnp.einsum('bhck,bhcv->bhkv', k * jnp.exp(g_last - gcum)[..., None], v_new))
    return S_new, o


def _gdn_scan(q, k, v, g, beta, S0):
    B, L = q.shape[0], q.shape[1]
    C = GDN_CHUNK if L % GDN_CHUNK == 0 else L
    n = L // C
    to_chunks = lambda t: jnp.moveaxis(t.reshape((B, n, C) + t.shape[2:]), (1, 3), (0, 2))
    S, o = lax.scan(_gdn_chunk, S0, (to_chunks(q), to_chunks(k), to_chunks(v), to_chunks(g), to_chunks(beta)))
    o = jnp.moveaxis(o, (0, 2), (1, 3)).reshape(B, L, GDN_HEADS, GDN_HEAD_V)
    return o, S


def _mixer(h, S0, gconv_hist, cconv_hist, n_lead, w_in, gdn_conv_w, A_log, dt_bias, gdn_norm_w,
           conf_dw_w, conf_dw_b, conf_ln_w, conf_ln_b, w_out):
    B, L, _ = h.shape
    p = jnp.einsum('bld,dc->blc', h, w_in)
    o0 = QKV_WIDTH
    o1 = o0 + GDN_HEADS
    o2 = o1 + GDN_HEADS
    o3 = o2 + GDN_WIDTH
    o4 = o3 + CONF_WIDTH
    o5 = o4 + CONF_WIDTH
    f32 = jnp.float32
    qkv, gconv_new = _causal_dwconv(p[..., :o0], gconv_hist, gdn_conv_w)
    qkv = jax.nn.silu(qkv).astype(f32)
    nk = GDN_HEADS * GDN_HEAD_K
    q = _l2norm(qkv[..., :nk].reshape(B, L, GDN_HEADS, GDN_HEAD_K)) * (GDN_HEAD_K ** -0.5)
    k = _l2norm(qkv[..., nk:2 * nk].reshape(B, L, GDN_HEADS, GDN_HEAD_K))
    v = qkv[..., 2 * nk:].reshape(B, L, GDN_HEADS, GDN_HEAD_V)
    g = -jnp.exp(A_log.astype(f32)) * jax.nn.softplus(p[..., o0:o1].astype(f32) + dt_bias.astype(f32))
    beta = jax.nn.sigmoid(p[..., o1:o2].astype(f32))
    S = S0.astype(f32)
    if n_lead > 0:
        o_a, S = _gdn_scan(q[:, :n_lead], k[:, :n_lead], v[:, :n_lead], g[:, :n_lead], beta[:, :n_lead], S)
        o_b, S = _gdn_scan(q[:, n_lead:], k[:, n_lead:], v[:, n_lead:], g[:, n_lead:], beta[:, n_lead:], S)
        o = jnp.concatenate([o_a, o_b], axis=1)
    else:
        o, S = _gdn_scan(q, k, v, g, beta, S)
    o = _rmsnorm(o, gdn_norm_w).reshape(B, L, GDN_WIDTH)
    gdn_out = (o * jax.nn.silu(p[..., o2:o3].astype(f32))).astype(h.dtype)
    glu = p[..., o3:o4] * jax.nn.sigmoid(p[..., o4:o5])
    c, cconv_new = _causal_dwconv(glu, cconv_hist, conf_dw_w)
    c = (c + conf_dw_b.astype(c.dtype)).astype(f32)
    mu = jnp.mean(c, axis=-1, keepdims=True)
    cc = c - mu
    c = cc * lax.rsqrt(jnp.mean(cc * cc, axis=-1, keepdims=True) + LN_EPS)
    c = c * conf_ln_w.astype(f32) + conf_ln_b.astype(f32)
    conf_out = (jax.nn.silu(c) * jax.nn.silu(p[..., o5:].astype(f32))).astype(h.dtype)
    y = jnp.einsum('blc,cd->bld', jnp.concatenate([gdn_out, conf_out], axis=-1), w_out)
    return y, S, gconv_new, cconv_new


def setup_inputs(seed: int = 0) -> dict:
    key = jax.random.key(seed)
    ks = jax.random.split(key, 20)
    f32 = jnp.float32
    nrm = lambda k, s, sc: jax.random.normal(k, s, f32) * sc
    dt = jnp.exp(jax.random.uniform(ks[9], (DEPTH, GDN_HEADS), f32, math.log(0.001), math.log(0.1)))
    return {
        "x_prompt": nrm(ks[0], (BATCH, SEQ, D_MODEL), 1.0),
        "x_sample": nrm(ks[1], (DEC_BATCH, DEC_SEQ, D_MODEL), 1.0),
        "state_gdn_S": nrm(ks[2], (DEPTH, DEC_BATCH, GDN_HEADS, GDN_HEAD_K, GDN_HEAD_V), GDN_HEAD_K ** -0.5),
        "state_gdn_conv": nrm(ks[3], (DEPTH, DEC_BATCH, SHORT_CONV - 1, QKV_WIDTH), 1.0),
        "state_conf_conv": nrm(ks[4], (DEPTH, DEC_BATCH, CONF_KERNEL - 1, CONF_WIDTH), 0.5),
        "meta_tokens": nrm(ks[5], (N_META, D_MODEL), 1.0),
        "norm_w": 1.0 + nrm(ks[6], (DEPTH, D_MODEL), 0.02),
        "w_in": nrm(ks[7], (DEPTH, D_MODEL, IN_COLS), D_MODEL ** -0.5),
        "gdn_conv_w": nrm(ks[8], (DEPTH, SHORT_CONV, QKV_WIDTH), SHORT_CONV ** -0.5),
        "gdn_A_log": jnp.log(jax.random.uniform(ks[10], (DEPTH, GDN_HEADS), f32, 1.0, 16.0)),
        "gdn_dt_bias": dt + jnp.log(-jnp.expm1(-dt)),
        "gdn_norm_w": 1.0 + nrm(ks[11], (DEPTH, GDN_HEAD_V), 0.02),
        "conf_dw_w": nrm(ks[12], (DEPTH, CONF_KERNEL, CONF_WIDTH), CONF_KERNEL ** -0.5),
        "conf_dw_b": nrm(ks[13], (DEPTH, CONF_WIDTH), 0.02),
        "conf_ln_w": 1.0 + nrm(ks[14], (DEPTH, CONF_WIDTH), 0.02),
        "conf_ln_b": nrm(ks[15], (DEPTH, CONF_WIDTH), 0.02),
        "w_out": nrm(ks[16], (DEPTH, MIX_WIDTH, D_MODEL), MIX_WIDTH ** -0.5),
        "final_norm_w": 1.0 + nrm(ks[17], (D_MODEL,), 0.02),
    }


def reference(x_prompt, x_sample, state_gdn_S, state_gdn_conv, state_conf_conv, meta_tokens,
              norm_w, w_in, gdn_conv_w, gdn_A_log, gdn_dt_bias, gdn_norm_w,
              conf_dw_w, conf_dw_b, conf_ln_w, conf_ln_b, w_out, final_norm_w):
    B = x_prompt.shape[0]
    meta = jnp.broadcast_to(meta_tokens.astype(x_prompt.dtype)[None], (B, N_META, D_MODEL))
    hp = jnp.concatenate([meta, x_prompt], axis=1)
    hs = x_sample
    Sp_l, gp_l, cp_l, Ss_l, gs_l, cs_l = [], [], [], [], [], []
    for l in range(DEPTH):
        w = (w_in[l], gdn_conv_w[l], gdn_A_log[l], gdn_dt_bias[l], gdn_norm_w[l],
             conf_dw_w[l], conf_dw_b[l], conf_ln_w[l], conf_ln_b[l], w_out[l])
        S0p = jnp.zeros((B, GDN_HEADS, GDN_HEAD_K, GDN_HEAD_V), jnp.float32)
        g0p = jnp.zeros((B, SHORT_CONV - 1, QKV_WIDTH), hp.dtype)
        c0p = jnp.zeros((B, CONF_KERNEL - 1, CONF_WIDTH), hp.dtype)
        yp, Sp, gp, cp = _mixer(_rmsnorm(hp, norm_w[l]), S0p, g0p, c0p, N_META, *w)
        hp = hp + yp
        ys, Ss, gs, cs = _mixer(_rmsnorm(hs, norm_w[l]), state_gdn_S[l], state_gdn_conv[l],
                                state_conf_conv[l], 0, *w)
        hs = hs + ys
        Sp_l.append(Sp.astype(state_gdn_S.dtype))
        gp_l.append(gp.astype(state_gdn_conv.dtype))
        cp_l.append(cp.astype(state_conf_conv.dtype))
        Ss_l.append(Ss.astype(state_gdn_S.dtype))
        gs_l.append(gs.astype(state_gdn_conv.dtype))
        cs_l.append(cs.astype(state_conf_conv.dtype))
    y_prompt = _rmsnorm(hp[:, N_META:], final_norm_w)
    y_sample = _rmsnorm(hs, final_norm_w)
    return (y_prompt, y_sample, jnp.stack(Sp_l), jnp.stack(gp_l), jnp.stack(cp_l),
            jnp.stack(Ss_l), jnp.stack(gs_l), jnp.stack(cs_l))
```

```cpp
#include <hip/hip_runtime.h>
#include <cstdio>
#include <cstdint>
namespace pg8 {
#define PG8_LAS __attribute__((address_space(3)))
typedef unsigned short bf16_t;
typedef short bf16x8 __attribute__((ext_vector_type(8)));
typedef float f32x4 __attribute__((ext_vector_type(4)));
typedef unsigned u32x4 __attribute__((ext_vector_type(4)));
constexpr int BM = 256, BK = 64, HALF = 128, HTB = HALF * BK * 2  , STAGE_BYTES = 8 * HTB, NXCD = 8, WGM = 8;

__host__ __device__ __forceinline__ int lds_byte(int r, int c) { const int st = (r >> 4) * 2 + (c >> 5), rr = r & 15, cc = c & 31, ob = rr * 64 + cc * 2; return st * 1024 + (ob ^ (((ob >> 9) & 1) << 5)); }
__host__ __device__ __forceinline__ void stage_rc(int b, int& R, int& C) { const int st = b / 1024, sb = b % 1024, swz = sb ^ (((sb >> 9) & 1) << 5); R = (st >> 1) * 16 + swz / 64; C = (st & 1) * 32 + (swz % 64) / 2; }
__host__ __device__ __forceinline__ int perm32(int rho) { const int n = rho >> 4, i = rho & 15; return 8 * (i >> 2) + 4 * n + (i & 3); }

struct Unit { int pm, pn; };
struct Gemm { const bf16_t* A; const bf16_t* Bt; int M, N, K; };

struct StaticOrder {
    int nM, nN, nwg, G, c;
    __host__ __device__ void init(int M, int N, int G_, int c_) { nM = M / BM; nN = N / BM; nwg = nM * nN; G = G_; c = c_; }
    __host__ __device__ bool next(int i, Unit& u) const {
        const long L = (long)i * G + c; if (L >= nwg) return false;
        int wgid = (int)L; { const int q = nwg / NXCD, r = nwg % NXCD, xcd = wgid % NXCD, off = wgid / NXCD; wgid = (xcd < r ? xcd * (q + 1) : r * (q + 1) + (xcd - r) * q) + off; }
        const int nig = WGM * nN, gid = wgid / nig, fm = gid * WGM, gsz = (nM - fm) < WGM ? (nM - fm) : WGM;
        u.pm = fm + ((wgid % nig) % gsz); u.pn = (wgid % nig) / gsz; return true;
    }
    __device__ __forceinline__ void a_ready(const Unit&) const {}
    __device__ __forceinline__ void done(const Unit&) const {}
};

__device__ __forceinline__ unsigned cvt_pk_bf16(float lo, float hi) { unsigned r; asm volatile("v_cvt_pk_bf16_f32 %0, %1, %2" : "=v"(r) : "v"(lo), "v"(hi)); return r; }
template <class Epi, class Sched, bool ALIGN_EPI = false, bool SP2 = false>
__device__ __forceinline__ void gemm_phase(PG8_LAS unsigned char* lds, const Gemm g, const Sched& S, const Epi& E) {
    const int tid = threadIdx.x, wid = __builtin_amdgcn_readfirstlane(tid >> 6), lane = tid & 63, wr = wid >> 2, wc = wid & 3, fr = lane & 15, fq = lane >> 4;
    const int K = g.K, nt = K / BK;
    unsigned voffA[2], voffB[2];
#pragma unroll
    for (int i = 0; i < 2; ++i) { int R, C; stage_rc(tid * 16 + i * 8192, R, C); const int Rb = Epi::PERM ? ((R & ~31) + perm32(R & 31)) : R;
        voffA[i] = (unsigned)(R * K + C) * 2u; voffB[i] = (unsigned)(Rb * K + C) * 2u; }
    const size_t kstep = (size_t)(BK * 2);
    const size_t hstep = (size_t)HALF * K * 2;
    const size_t tstep = 2 * hstep;
    const unsigned ldsw = (unsigned)wid * 1024u;
    const int aoff = lds_byte(wr * 64 + fr, fq * 8), boff = lds_byte(wc * 32 + fr, fq * 8);
#define PG8_SA(b, h) (((b) * 2 + (h)) * HTB)
#define PG8_SB(b, h) ((4 + (b) * 2 + (h)) * HTB)
#define PG8_STAGE(bufoff, gbase, voff) do { _Pragma("unroll") for (int _i = 0; _i < 2; ++_i) \
        __builtin_amdgcn_global_load_lds((const unsigned*)((const char*)(gbase) + (voff)[_i]), (PG8_LAS unsigned*)(lds + (bufoff) + ldsw + _i * 8192), 16, 0, 0); } while (0)
#define PG8_LDA(dst, b, h) do { _Pragma("unroll") for (int m = 0; m < 4; ++m) _Pragma("unroll") for (int k = 0; k < 2; ++k) dst[m][k] = *(const PG8_LAS bf16x8*)(lds + PG8_SA(b, h) + aoff + m * 2048 + k * 1024); } while (0)
#define PG8_LDB(dst, b, h) do { _Pragma("unroll") for (int n = 0; n < 2; ++n) _Pragma("unroll") for (int k = 0; k < 2; ++k) dst[n][k] = *(const PG8_LAS bf16x8*)(lds + PG8_SB(b, h) + boff + n * 2048 + k * 1024); } while (0)
#define PG8_MMA(ai, bj, At, Bt) do { __builtin_amdgcn_s_setprio(1); _Pragma("unroll") for (int m = 0; m < 4; ++m) _Pragma("unroll") for (int n = 0; n < 2; ++n) _Pragma("unroll") for (int k = 0; k < 2; ++k) \
        acc[ai][bj][m][n] = __builtin_amdgcn_mfma_f32_16x16x32_bf16(Bt[n][k], At[m][k], acc[ai][bj][m][n], 0, 0, 0); __builtin_amdgcn_s_setprio(0); } while (0)
#define PG8_WAIT_V(n) asm volatile("s_waitcnt vmcnt(" #n ")" ::: "memory")
#define PG8_WAIT_L(n) asm volatile("s_waitcnt lgkmcnt(" #n ")" ::: "memory")
#define PG8_BAR __builtin_amdgcn_s_barrier()
#define PG8_SCHED __builtin_amdgcn_sched_barrier(0)
    Unit cur, nxt; int ui = 0;
    if (!S.next(0, cur)) return;
    f32x4 acc[2][2][4][2];
#pragma unroll
    for (int a = 0; a < 2; ++a)
#pragma unroll
        for (int b = 0; b < 2; ++b)
#pragma unroll
            for (int m = 0; m < 4; ++m)
#pragma unroll
                for (int n = 0; n < 2; ++n) acc[a][b][m][n] = (f32x4){0.f, 0.f, 0.f, 0.f};
    bf16x8 At[4][2], B0[2][2], B1[2][2];
    const char* cA = (const char*)g.A + (size_t)cur.pm * tstep; const char* cB = (const char*)g.Bt + (size_t)cur.pn * tstep;
    S.a_ready(cur);
    if constexpr (SP2) {
        PG8_STAGE(PG8_SB(0, 0), cB, voffB); PG8_STAGE(PG8_SB(0, 1), cB + hstep, voffB); PG8_STAGE(PG8_SA(0, 0), cA, voffA); PG8_STAGE(PG8_SA(0, 1), cA + hstep, voffA);
        if (wr == 1) PG8_BAR;
        PG8_WAIT_V(2); PG8_BAR;
        PG8_STAGE(PG8_SB(1, 0), cB + kstep, voffB); PG8_STAGE(PG8_SA(1, 0), cA + kstep, voffA); PG8_STAGE(PG8_SB(1, 1), cB + hstep + kstep, voffB);
        PG8_WAIT_V(6); PG8_BAR;
    } else {
        PG8_STAGE(PG8_SB(0, 0), cB, voffB); PG8_STAGE(PG8_SA(0, 0), cA, voffA); PG8_STAGE(PG8_SB(0, 1), cB + hstep, voffB); PG8_STAGE(PG8_SA(0, 1), cA + hstep, voffA);
        if (wr == 1) PG8_BAR;
        PG8_WAIT_V(4); PG8_BAR;
        PG8_STAGE(PG8_SB(1, 0), cB + kstep, voffB); PG8_STAGE(PG8_SA(1, 0), cA + kstep, voffA); PG8_STAGE(PG8_SB(1, 1), cB + hstep + kstep, voffB);
        PG8_WAIT_V(6); PG8_BAR;
    }
    for (;;) {
        const bool has_next = S.next(ui + 1, nxt);
        const char* nA = has_next ? (const char*)g.A + (size_t)nxt.pm * tstep : cA; const char* nB = has_next ? (const char*)g.Bt + (size_t)nxt.pn * tstep : cB;
        for (int t = 0; t < nt; t += 2) {
            const bool last = (t == nt - 2);
            const char* a1 = cA + (size_t)(t + 1) * kstep;
            const char* a2 = last ? nA : cA + (size_t)(t + 2) * kstep; const char* b2 = last ? nB : cB + (size_t)(t + 2) * kstep;
            const char* a3 = a2 + kstep; const char* b3 = b2 + kstep;
            if (last && has_next) S.a_ready(nxt);
            if constexpr (SP2) {
            PG8_LDB(B0, 0, 0); PG8_LDB(B1, 0, 1); PG8_SCHED; PG8_LDA(At, 0, 0); PG8_STAGE(PG8_SA(1, 1), a1 + hstep, voffA);
            PG8_WAIT_V(8); PG8_WAIT_L(0); PG8_BAR; PG8_MMA(0, 0, At, B0); PG8_MMA(0, 1, At, B1); PG8_BAR; PG8_SCHED;
            PG8_LDA(At, 0, 1); PG8_STAGE(PG8_SB(0, 0), b2, voffB); PG8_STAGE(PG8_SB(0, 1), b2 + hstep, voffB); PG8_STAGE(PG8_SA(0, 0), a2, voffA);
            PG8_WAIT_V(8); PG8_WAIT_L(0); PG8_BAR; PG8_MMA(1, 0, At, B0); PG8_MMA(1, 1, At, B1); PG8_BAR; PG8_SCHED;
            PG8_LDB(B0, 1, 0); PG8_LDB(B1, 1, 1); PG8_SCHED; PG8_LDA(At, 1, 0); PG8_STAGE(PG8_SA(0, 1), a2 + hstep, voffA);
            PG8_WAIT_V(8); PG8_WAIT_L(0); PG8_BAR; PG8_MMA(0, 0, At, B0); PG8_MMA(0, 1, At, B1); PG8_BAR; PG8_SCHED;
            PG8_LDA(At, 1, 1); PG8_STAGE(PG8_SB(1, 0), b3, voffB); PG8_STAGE(PG8_SB(1, 1), b3 + hstep, voffB); PG8_STAGE(PG8_SA(1, 0), a3, voffA);
            PG8_WAIT_V(8); PG8_WAIT_L(0); PG8_BAR; PG8_MMA(1, 0, At, B0); PG8_MMA(1, 1, At, B1); PG8_BAR; PG8_SCHED;
            } else {
            PG8_LDB(B0, 0, 0); PG8_SCHED; PG8_LDA(At, 0, 0); PG8_STAGE(PG8_SA(1, 1), a1 + hstep, voffA);
            PG8_WAIT_L(8); PG8_BAR; PG8_WAIT_L(0); PG8_MMA(0, 0, At, B0); PG8_BAR; PG8_SCHED;
            PG8_LDB(B1, 0, 1); PG8_STAGE(PG8_SB(0, 0), b2, voffB);
            PG8_BAR; PG8_WAIT_L(0); PG8_MMA(0, 1, At, B1); PG8_BAR;
            PG8_LDA(At, 0, 1); PG8_STAGE(PG8_SA(0, 0), a2, voffA);
            PG8_BAR; PG8_WAIT_L(0); PG8_MMA(1, 0, At, B0); PG8_BAR; PG8_SCHED;
            PG8_STAGE(PG8_SB(0, 1), b2 + hstep, voffB);
            PG8_WAIT_V(6); PG8_BAR; PG8_MMA(1, 1, At, B1); PG8_BAR;
            PG8_LDB(B0, 1, 0); PG8_SCHED; PG8_LDA(At, 1, 0); PG8_STAGE(PG8_SA(0, 1), a2 + hstep, voffA);
            PG8_WAIT_L(8); PG8_BAR; PG8_WAIT_L(0); PG8_MMA(0, 0, At, B0); PG8_BAR; PG8_SCHED;
            PG8_LDB(B1, 1, 1); PG8_STAGE(PG8_SB(1, 0), b3, voffB);
            PG8_BAR; PG8_WAIT_L(0); PG8_MMA(0, 1, At, B1); PG8_BAR;
            PG8_LDA(At, 1, 1); PG8_STAGE(PG8_SA(1, 0), a3, voffA);
            PG8_BAR; PG8_WAIT_L(0); PG8_MMA(1, 0, At, B0); PG8_BAR; PG8_SCHED;
            PG8_STAGE(PG8_SB(1, 1), b3 + hstep, voffB);
            PG8_WAIT_V(6); PG8_BAR; PG8_MMA(1, 1, At, B1); PG8_BAR;
            }
        }
        if constexpr (ALIGN_EPI) { if (wr == 0) PG8_BAR; }
        if constexpr (!Epi::AFTER_DRAIN) { E(acc, cur, wr, wc, fr, fq); S.done(cur); }
        if (!has_next) break;
#pragma unroll
        for (int a = 0; a < 2; ++a)
#pragma unroll
            for (int b = 0; b < 2; ++b)
#pragma unroll
                for (int m = 0; m < 4; ++m)
#pragma unroll
                    for (int n = 0; n < 2; ++n) acc[a][b][m][n] = (f32x4){0.f, 0.f, 0.f, 0.f};
        cur = nxt; cA = nA; cB = nB; ++ui;
        if constexpr (ALIGN_EPI) { if (wr == 1) PG8_BAR; }
    }
    PG8_WAIT_V(0);
    if constexpr (!ALIGN_EPI) { if (wr == 0) PG8_BAR; }
    PG8_BAR;
    if constexpr (Epi::AFTER_DRAIN) { E.fused(acc, cur, wr, wc, fr, fq, lds, wid, lane); S.done(cur); }
#undef PG8_SA
#undef PG8_SB
#undef PG8_STAGE
#undef PG8_LDA
#undef PG8_LDB
#undef PG8_MMA
#undef PG8_WAIT_V
#undef PG8_WAIT_L
#undef PG8_BAR
#undef PG8_SCHED
}
}
#define GAS __attribute__((address_space(1)))
#define LAS __attribute__((address_space(3)))
typedef unsigned short bf16;
typedef float f32x4 __attribute__((ext_vector_type(4)));
typedef unsigned u32x4 __attribute__((ext_vector_type(4)));
typedef GAS unsigned gu32;
#define LDS_WAIT() asm volatile("s_waitcnt lgkmcnt(0)" ::: "memory")
#define XB_TMO      128
#define XB_XCNT(j)  (256  + 64 * (j))
#define XB_XSUB(j)  (1280 + 64 * (j))
#define XB_XGEN(j)  (2304 + 64 * (j))
#define XB_TOP      3328
#define XB_TOPGEN   3392
#define XCD_BAR_WORDS 3456
#define XB_SPIN_CAP (1u << 18)

__device__ __forceinline__ unsigned xb_ld(unsigned* p)              { return __hip_atomic_load(p, __ATOMIC_RELAXED, __HIP_MEMORY_SCOPE_AGENT); }
__device__ __forceinline__ unsigned xb_add(unsigned* p, unsigned v) { return __hip_atomic_fetch_add(p, v, __ATOMIC_RELAXED, __HIP_MEMORY_SCOPE_AGENT); }
__device__ __forceinline__ unsigned xb_xcc_id() { return (unsigned)__builtin_amdgcn_s_getreg((3 << 11) | 20) & 0xFu; }
#define XB_SPIN(cond, bar) do { unsigned _sp = 0; while (cond) { __builtin_amdgcn_s_sleep(1); \
    if ((++_sp & 255u) == 0u) { if (xb_ld(&(bar)[XB_TMO])) break; if (_sp > XB_SPIN_CAP) { atomicAdd(&(bar)[XB_TMO], 1u); break; } } } } while (0)

struct XcdBarrier {
    unsigned* bar; unsigned x;
    volatile LAS unsigned* st;
};

__device__ __forceinline__ XcdBarrier xcd_barrier_post(unsigned* bar, volatile LAS unsigned* st) {
    XcdBarrier b; b.bar = bar; b.x = xb_xcc_id(); b.st = st;
    if (threadIdx.x == 0) (void)xb_add(&bar[XB_XCNT(b.x)], 1u);
    return b;
}
__device__ __forceinline__ void xcd_barrier_complete(unsigned* bar, unsigned x, unsigned& nloc, unsigned& nx) {
    const unsigned G = gridDim.x * gridDim.y * gridDim.z;
    unsigned sum, cnt, mine, sp = 0u;
    for (;;) {
        sum = 0u; cnt = 0u; mine = 0u;
#pragma unroll
        for (unsigned j = 0; j < 16; ++j) { const unsigned c = xb_ld(&bar[XB_XCNT(j)]); sum += c; cnt += (c > 0u) ? 1u : 0u; mine = (j == x) ? c : mine; }
        if (sum == G) break;
        __builtin_amdgcn_s_sleep(1);
        if ((++sp & 255u) == 0u) { if (xb_ld(&bar[XB_TMO])) break; if (sp > XB_SPIN_CAP) { atomicAdd(&bar[XB_TMO], 1u); break; } }
    }
    nloc = mine > 0u ? mine : 1u; nx = cnt > 0u ? cnt : 1u;
}

__device__ __forceinline__ void xcd_barrier(const XcdBarrier& b) {
    asm volatile("s_waitcnt vmcnt(0)" ::: "memory");
    __syncthreads();
    if (threadIdx.x == 0) {
        unsigned* bar = b.bar;
        __builtin_amdgcn_s_waitcnt(0);
        unsigned nloc = b.st[0], nx = b.st[1];
        if (nloc == 0u) { xcd_barrier_complete(bar, b.x, nloc, nx); b.st[0] = nloc; b.st[1] = nx; }
        const unsigned old = xb_add(&bar[XB_XSUB(b.x)], 1u);
        const unsigned gen = old / nloc;
        if (old + 1u == (gen + 1u) * nloc) {
            __builtin_amdgcn_fence(__ATOMIC_RELEASE, "agent");
            asm volatile("s_waitcnt vmcnt(0)" ::: "memory");
            const unsigned og = xb_add(&bar[XB_TOP], 1u);
            const unsigned tg = og / nx;
            if (og + 1u == (tg + 1u) * nx) xb_add(&bar[XB_TOPGEN], 1u);
            else XB_SPIN(xb_ld(&bar[XB_TOPGEN]) == tg, bar);
            __builtin_amdgcn_fence(__ATOMIC_ACQUIRE, "agent");
            xb_add(&bar[XB_XGEN(b.x)], 1u);
            asm volatile("s_waitcnt vmcnt(0)" ::: "memory");
        } else {
            XB_SPIN(xb_ld(&bar[XB_XGEN(b.x)]) == gen, bar);
            __builtin_amdgcn_fence(__ATOMIC_ACQUIRE, "agent");
            asm volatile("s_waitcnt vmcnt(0)" ::: "memory");
        }
    }
    __syncthreads();
}

#ifndef MK_N_LAUNCHES
#define DBG_NOSG 0
#define MK_N_LAUNCHES 1
#endif
constexpr int NWAVES = 8, NPHASE = 6;
constexpr int DM = 2048, NB = 4, SEQ = 2048, NS = 128, NH = 8;
constexpr int M1 = 8448, N1 = 7424;
constexpr int ROW_META = 8192, ROW_SAMP = 8208, ROWS1 = 8336;
constexpr int M2 = 8448, ROWS2 = 8320;
constexpr int NREC = 8 + NB * 32 * NH;
constexpr int REC_ELEMS = 49152, REC_N = 0, REC_Q = 16384, REC_B = 24576, REC_O = 40960;
constexpr float RMS_EPS = 1e-6f, LN_EPS = 1e-5f;
constexpr size_t O_Y = 0, O_YS = 16777216, O_SP = 17039360, O_GP = 17563648, O_CP = 17600512, O_SS = 17723392, O_GS = 34500608, O_CS = 35680256, O_END = 39612416;
constexpr size_t MiB = 1u << 20;
constexpr size_t WS_CTL = 0, CTL_ZERO_BYTES = 65536;
constexpr size_t WS_AB = 1 * MiB, WS_ROWSS = 1 * MiB + 768 * 1024, WS_DEC = 1 * MiB + 896 * 1024;
constexpr size_t WS_WT2 = 2 * MiB;
constexpr size_t WS_QKV = 10 * MiB;
constexpr size_t WS_ZG = WS_QKV + (size_t)M1 * 3072 * 2;
constexpr size_t WS_GLU = WS_ZG + (size_t)M1 * 1024 * 2;
constexpr size_t WS_ZC = WS_GLU + (size_t)M1 * 1024 * 2;
constexpr size_t WS_A2 = WS_ZC + (size_t)M1 * 1024 * 2;
constexpr size_t WS_REC = WS_A2 + (size_t)M2 * 2048 * 2;
constexpr size_t WS_XN = WS_REC;
constexpr size_t WS_WT1 = WS_XN + (size_t)M1 * 2048 * 2;
constexpr size_t WS_END = WS_REC + (size_t)NREC * REC_ELEMS * 2;
static_assert(WS_WT1 + (size_t)N1 * 2048 * 2 <= WS_END && WS_END <= 256 * MiB, "d_ws map");
static_assert(WS_AB + (size_t)M1 * 16 * 4 <= WS_ROWSS && WS_ROWSS + M2 * 4 <= WS_DEC && WS_DEC + NREC * 4 <= WS_WT2 && WS_WT2 + 2048u * 2048u * 2 <= WS_QKV, "d_ws map (small)");
constexpr int CW_TMO = 0, CW_CODE = 1, CW_BAR = 4096;
constexpr int LDS_BYTES = 147456, LDSCTL_OFF = 139264, MISC_OFF = LDSCTL_OFF + 320;

#define DI __device__ __forceinline__
typedef short bf16x8 __attribute__((ext_vector_type(8)));
typedef float f32x2 __attribute__((ext_vector_type(2)));
typedef unsigned u32x2 __attribute__((ext_vector_type(2)));
DI float bf_lo(unsigned u) { return __uint_as_float(u << 16); }
DI float bf_hi(unsigned u) { return __uint_as_float(u & 0xffff0000u); }
DI float bf2f(bf16 b) { return __uint_as_float((unsigned)b << 16); }
typedef __bf16 bf16x2_t __attribute__((ext_vector_type(2)));
DI unsigned pk(float lo, float hi) { f32x2 v = {lo, hi}; const bf16x2_t b = __builtin_convertvector(v, bf16x2_t); return __builtin_bit_cast(unsigned, b); }
DI bf16 f2b(float v) { return (bf16)(pk(v, 0.f) & 0xffffu); }
DI float sigm(float x) { return 1.f / (1.f + __expf(-x)); }
DI float silu(float x) { return x / (1.f + __expf(-x)); }
DI f32x4 mfma16(bf16x8 a, bf16x8 b, f32x4 c) { return __builtin_amdgcn_mfma_f32_16x16x32_bf16(a, b, c, 0, 0, 0); }
DI float wave_sum(float v) {
#pragma unroll
    for (int o = 1; o < 64; o <<= 1) v += __shfl_xor(v, o);
    return v;
}
DI float dot4(f32x4 a) { return (a.x * a.x + a.y * a.y) + (a.z * a.z + a.w * a.w); }

DI LAS unsigned char* opaque_lds(LAS unsigned char* p) { unsigned v = (unsigned)(uintptr_t)p; asm volatile("" : "+s"(v)); return (LAS unsigned char*)(uintptr_t)v; }
struct Ctx {
    const float *xp, *xs, *sS, *sgc, *scc, *meta, *normw, *win, *gcw, *alog, *dtb, *gnw, *cdw, *cdb, *clw, *clb, *wout, *fnw;
    float* out;
    gu32* ctl; float* AB; float* ROWSS; float* DEC;
    bf16 *WT1, *WT2, *XN, *QKV, *ZG, *GLU, *ZC, *A2, *REC;
    int tid, lane, wave, vcu, G, bx;
};

DI int orig_col(int n) {
    if (n < 3072) return n;
    if (n < 4096) return n + 16;
    if (n < 6144) { const int q = n - 4096, T = q >> 8, w = q & 255; return (w < 128) ? 4112 + T * 128 + w : 5136 + T * 128 + (w - 128); }
    if (n < 7168) return 6160 + (n - 6144);
    if (n < 7184) return 3072 + (n - 7168);
    return -1;
}
DI void p0_transpose_item(const float* W, int ldw, int K, bf16* WT, bool mapcols, LAS float* scr, int item, int nblk, int lane) {
    const int kb = item / nblk, nb = item % nblk, k0 = 64 * kb, n0 = 32 * nb;
    const int nn = n0 + (lane & 31); const int oc = mapcols ? orig_col(nn) : nn;
#pragma unroll 8
    for (int i = 0; i < 32; ++i) { const int kk = 2 * i + (lane >> 5); scr[kk * 33 + (lane & 31)] = oc >= 0 ? W[(size_t)(k0 + kk) * ldw + oc] : 0.f; }
    LDS_WAIT(); asm volatile("" ::: "memory");
    const int c = lane & 7;
#pragma unroll
    for (int j = 0; j < 4; ++j) { const int n = (lane >> 3) + 8 * j; const LAS float* s = scr + (8 * c) * 33 + n;
        u32x4 o; o.x = pk(s[0 * 33], s[1 * 33]); o.y = pk(s[2 * 33], s[3 * 33]); o.z = pk(s[4 * 33], s[5 * 33]); o.w = pk(s[6 * 33], s[7 * 33]);
        *(u32x4*)(WT + (size_t)(n0 + n) * K + k0 + 8 * c) = o; }
    LDS_WAIT(); asm volatile("" ::: "memory");
}
DI void p0_prologue(const Ctx& C, LAS unsigned char* lds) {
    LAS float* scr = (LAS float*)(lds + C.wave * 16384);
    const int gw = C.vcu * NWAVES + C.wave, NGW = C.G * NWAVES;
    constexpr int I1 = (DM / 64) * (N1 / 32), I2 = (DM / 64) * (DM / 32);
    for (int it = gw; it < I1 + I2; it += NGW) {
        if (it < I1) p0_transpose_item(C.win, 7184, DM, C.WT1, true, scr, it, N1 / 32, C.lane);
        else p0_transpose_item(C.wout, DM, DM, C.WT2, false, scr, it - I1, DM / 32, C.lane);
    }
    for (int m = gw; m < ROWS1; m += NGW) {
        const float* xr = m < ROW_META ? C.xp + (size_t)m * DM : (m < ROW_SAMP ? C.meta + (size_t)(m - ROW_META) * DM : C.xs + (size_t)(m - ROW_SAMP) * DM);
        f32x4 v[8]; float s = 0.f;
#pragma unroll
        for (int j = 0; j < 8; ++j) { v[j] = *(const f32x4*)(xr + 4 * C.lane + 256 * j); s += dot4(v[j]); }
        const float rs = rsqrtf(wave_sum(s) * (1.f / DM) + RMS_EPS);
        bf16* orow = C.XN + (size_t)m * DM;
#pragma unroll
        for (int j = 0; j < 8; ++j) { const f32x4 w = *(const f32x4*)(C.normw + 4 * C.lane + 256 * j);
            u32x2 o; o.x = pk(v[j].x * rs * w.x, v[j].y * rs * w.y); o.y = pk(v[j].z * rs * w.z, v[j].w * rs * w.w);
            *(u32x2*)(orow + 4 * C.lane + 256 * j) = o; }
    }
    for (int i = C.vcu * 512 + C.tid; i < M2; i += C.G * 512) C.ROWSS[i] = 0.f;
}

struct EpiP1 {
    static constexpr bool PERM = true, AFTER_DRAIN = false;
    bf16 *QKV, *ZG, *GLU, *ZC; float* AB;
    DI void operator()(const f32x4 (&acc)[2][2][4][2], const pg8::Unit& u, int wr, int wc, int fr, int fq) const {
        const int row0 = u.pm * 256 + wr * 64 + fr, pn = u.pn, cl = wc * 32 + 8 * fq;
        if (pn < 16 || (pn >= 24 && pn < 28)) {
            bf16* base; int ld, col0; bool act;
            if (pn < 12) { base = QKV; ld = 3072; col0 = pn * 256; act = false; }
            else if (pn < 16) { base = ZG; ld = 1024; col0 = (pn - 12) * 256; act = true; }
            else { base = ZC; ld = 1024; col0 = (pn - 24) * 256; act = true; }
#pragma unroll
            for (int ai = 0; ai < 2; ++ai)
#pragma unroll
                for (int m = 0; m < 4; ++m) { bf16* rowp = base + (size_t)(row0 + ai * 128 + m * 16) * ld + col0 + cl;
#pragma unroll
                    for (int bj = 0; bj < 2; ++bj) { f32x4 v0 = acc[ai][bj][m][0], v1 = acc[ai][bj][m][1];
                        if (act) { v0 = (f32x4){silu(v0.x), silu(v0.y), silu(v0.z), silu(v0.w)}; v1 = (f32x4){silu(v1.x), silu(v1.y), silu(v1.z), silu(v1.w)}; }
                        u32x4 w; w.x = pk(v0.x, v0.y); w.y = pk(v0.z, v0.w); w.z = pk(v1.x, v1.y); w.w = pk(v1.z, v1.w);
                        *(u32x4*)(rowp + bj * 128) = w; } }
        } else if (pn < 24) {
            const int T = pn - 16;
#pragma unroll
            for (int ai = 0; ai < 2; ++ai)
#pragma unroll
                for (int m = 0; m < 4; ++m) { bf16* rowp = GLU + (size_t)(row0 + ai * 128 + m * 16) * 1024 + T * 128 + cl;
                    const f32x4 a0 = acc[ai][0][m][0], a1 = acc[ai][0][m][1], b0 = acc[ai][1][m][0], b1 = acc[ai][1][m][1];
                    u32x4 w; w.x = pk(a0.x * sigm(b0.x), a0.y * sigm(b0.y)); w.y = pk(a0.z * sigm(b0.z), a0.w * sigm(b0.w));
                    w.z = pk(a1.x * sigm(b1.x), a1.y * sigm(b1.y)); w.w = pk(a1.z * sigm(b1.z), a1.w * sigm(b1.w));
                    *(u32x4*)rowp = w; }
        } else {
            if (wc == 0 && fq < 2) {
#pragma unroll
                for (int ai = 0; ai < 2; ++ai)
#pragma unroll
                    for (int m = 0; m < 4; ++m) { float* rowp = AB + (size_t)(row0 + ai * 128 + m * 16) * 16 + 8 * fq;
                        *(f32x4*)rowp = acc[ai][0][m][0]; *(f32x4*)(rowp + 4) = acc[ai][0][m][1]; }
            }
        }
    }
};
struct EpiRes {
    static constexpr bool PERM = false, AFTER_DRAIN = false;
    const float *xp, *xs; float* out; float* rowss; int row_base;
    DI void operator()(const f32x4 (&acc)[2][2][4][2], const pg8::Unit& u, int wr, int wc, int fr, int fq) const {
        const int col0 = u.pn * 256 + wc * 32 + 4 * fq;
#pragma unroll
        for (int ai = 0; ai < 2; ++ai)
#pragma unroll
            for (int m = 0; m < 4; ++m) {
                const int grow = row_base + u.pm * 256 + ai * 128 + wr * 64 + m * 16 + fr;
                if (grow < ROWS2) {
                    const float* xr = grow < 8192 ? xp + (size_t)grow * DM : xs + (size_t)(grow - 8192) * DM;
                    float* orow = grow < 8192 ? out + O_Y + (size_t)grow * DM : out + O_YS + (size_t)(grow - 8192) * DM;
                    float ss = 0.f;
#pragma unroll
                    for (int bj = 0; bj < 2; ++bj)
#pragma unroll
                        for (int n = 0; n < 2; ++n) { const int c = col0 + bj * 128 + n * 16; const f32x4 hv = *(const f32x4*)(xr + c) + acc[ai][bj][m][n]; *(f32x4*)(orow + c) = hv; ss += dot4(hv); }
                    ss += __shfl_xor(ss, 16); ss += __shfl_xor(ss, 32);
                    if (fq == 0) atomicAdd(rowss + grow, ss);
                }
            }
    }
};

DI int rowof(int b, int pos) { return pos < 48 ? -1 : (pos < 64 ? ROW_META + pos - 48 : b * SEQ + pos - 64); }
DI void p2_gdn_item(const Ctx& C, int item, LAS unsigned char* lds_in) {
    LAS unsigned char* lds = opaque_lds(lds_in);
    const int tid = C.tid, lane = C.lane, wave = C.wave, fr = lane & 15, fq = lane >> 4;
    int b, cp, h;
    if (item < 8) { b = 0; cp = 0; h = item; } else { int r = item - 8; h = r & 7; r >>= 3; cp = 1 + (r & 31); b = r >> 5; }
    LAS bf16* LQ = (LAS bf16*)(lds + 0);
    LAS bf16* LK = (LAS bf16*)(lds + 17408);
    LAS float* LA = (LAS float*)(lds + 35840);
    LAS bf16* LKT = (LAS bf16*)(lds + 54272);
    LAS bf16* LKD = (LAS bf16*)(lds + 72704);
    LAS bf16* LVT = (LAS bf16*)(lds + 91136);
    LAS bf16* LP = (LAS bf16*)(lds + 109568);
    LAS bf16* LTK = (LAS bf16*)(lds + 118784);
    LAS bf16* LTV = (LAS bf16*)(lds + 128000);
    LAS float* SMG = (LAS float*)(lds + 137216);
    LAS bf16* LWT = LK;
    LAS bf16* LUT = (LAS bf16*)(lds + 35840);
    bf16* R = C.REC + (size_t)item * REC_ELEMS;
    if (wave == 0) {
        const int row = rowof(b, 64 * cp + lane);
        float g = 0.f, be = 0.f;
        if (row >= 0) { const float al = C.AB[(size_t)row * 16 + h], br = C.AB[(size_t)row * 16 + 8 + h];
            const float x = al + C.dtb[h]; const float sp = x > 20.f ? x : log1pf(__expf(x));
            g = -__expf(C.alog[h]) * sp; be = sigm(br); }
        float gc = g;
#pragma unroll
        for (int o = 1; o < 64; o <<= 1) { const float v = __shfl_up(gc, o); if (lane >= o) gc += v; }
        const float gl = __shfl(gc, 63);
        SMG[lane] = gc; SMG[64 + lane] = be; SMG[128 + lane] = __expf(gl - gc); SMG[192 + lane] = __expf(gc);
        if (lane == 0) C.DEC[item] = __expf(gl);
    }
    __syncthreads();
#pragma unroll 1
    for (int i = 0; i < 2; ++i) {
        const int idx = tid + 512 * i, t = idx >> 4, cg = idx & 15;
        int rows[4];
#pragma unroll
        for (int j = 0; j < 4; ++j) rows[j] = rowof(b, 64 * cp + t - 3 + j);
        const float et = SMG[128 + t];
#pragma unroll 1
        for (int z = 0; z < 3; ++z) {
            const int col = z * 1024 + h * 128 + cg * 8;
            float y[8];
#pragma unroll
            for (int e = 0; e < 8; ++e) y[e] = 0.f;
#pragma unroll
            for (int j = 0; j < 4; ++j) {
                if (rows[j] >= 0) {
                    const u32x4 raw = *(const u32x4*)(C.QKV + (size_t)rows[j] * 3072 + col);
                    const f32x4 w0 = *(const f32x4*)(C.gcw + j * 3072 + col), w1 = *(const f32x4*)(C.gcw + j * 3072 + col + 4);
                    y[0] += w0.x * bf_lo(raw.x); y[1] += w0.y * bf_hi(raw.x); y[2] += w0.z * bf_lo(raw.y); y[3] += w0.w * bf_hi(raw.y);
                    y[4] += w1.x * bf_lo(raw.z); y[5] += w1.y * bf_hi(raw.z); y[6] += w1.z * bf_lo(raw.w); y[7] += w1.w * bf_hi(raw.w);
                }
            }
            float ss = 0.f;
#pragma unroll
            for (int e = 0; e < 8; ++e) { y[e] = silu(y[e]); ss += y[e] * y[e]; }
            if (z < 2) {
                ss += __shfl_xor(ss, 1); ss += __shfl_xor(ss, 2); ss += __shfl_xor(ss, 4); ss += __shfl_xor(ss, 8);
                const float sc = rsqrtf(ss + RMS_EPS) * (z == 0 ? 0.08838834764831845f : 1.f);
#pragma unroll
                for (int e = 0; e < 8; ++e) y[e] *= sc;
            }
            u32x4 pw; pw.x = pk(y[0], y[1]); pw.y = pk(y[2], y[3]); pw.z = pk(y[4], y[5]); pw.w = pk(y[6], y[7]);
            if (z == 0) *(LAS u32x4*)(LQ + t * 136 + cg * 8) = pw;
            else if (z == 1) {
                *(LAS u32x4*)(LK + t * 144 + cg * 8) = pw;
#pragma unroll
                for (int e = 0; e < 8; ++e) { LKT[(cg * 8 + e) * 72 + t] = f2b(y[e]); LKD[(cg * 8 + e) * 72 + t] = f2b(y[e] * et); }
            } else {
#pragma unroll
                for (int e = 0; e < 8; ++e) LVT[(cg * 8 + e) * 72 + t] = f2b(y[e]);
            }
        }
    }
    __syncthreads();
    {
        const int kind = wave >> 2, ti = wave & 3;
#pragma unroll
        for (int tj = 0; tj < 4; ++tj) {
            if (tj <= ti) {
                f32x4 acc = {0.f, 0.f, 0.f, 0.f};
#pragma unroll
                for (int s = 0; s < 4; ++s) {
                    const bf16x8 a = kind == 0 ? *(const LAS bf16x8*)(LK + (16 * ti + fr) * 144 + 32 * s + 8 * fq) : *(const LAS bf16x8*)(LQ + (16 * ti + fr) * 136 + 32 * s + 8 * fq);
                    const bf16x8 bb = *(const LAS bf16x8*)(LK + (16 * tj + fr) * 144 + 32 * s + 8 * fq);
                    acc = mfma16(a, bb, acc);
                }
                const int j = 16 * tj + fr; const float gj = SMG[j];
#pragma unroll
                for (int r = 0; r < 4; ++r) { const int i = 16 * ti + 4 * fq + r; const float gm = __expf(fminf(SMG[i] - gj, 0.f));
                    if (kind == 0) LA[i * 72 + j] = (i > j) ? SMG[64 + i] * acc[r] * gm : 0.f;
                    else LP[i * 72 + j] = f2b((i >= j) ? acc[r] * gm : 0.f); }
            } else if (kind == 1) {
#pragma unroll
                for (int r = 0; r < 4; ++r) LP[(16 * ti + 4 * fq + r) * 72 + 16 * tj + fr] = (bf16)0;
            }
        }
    }
    __syncthreads();
    if (wave == 0) {
        float x[64];
#pragma unroll
        for (int i = 0; i < 64; ++i) {
            float acc = (lane == i) ? 1.f : 0.f;
#pragma unroll
            for (int m4 = 0; m4 < i; m4 += 4) {
                const f32x4 a = *(const LAS f32x4*)(LA + i * 72 + m4);
                acc -= a.x * x[m4];
                if (m4 + 1 < i) acc -= a.y * x[m4 + 1];
                if (m4 + 2 < i) acc -= a.z * x[m4 + 2];
                if (m4 + 3 < i) acc -= a.w * x[m4 + 3];
            }
            x[i] = acc;
        }
        const float cb = SMG[64 + lane], ck = cb * SMG[192 + lane];
#pragma unroll
        for (int i = 0; i < 64; ++i) { LTK[i * 72 + lane] = f2b(x[i] * ck); LTV[i * 72 + lane] = f2b(x[i] * cb); }
    }
    __syncthreads();
    {
        const int tens = wave >> 2, ti = wave & 3;
        const LAS bf16* T = tens == 0 ? LTK : LTV; const LAS bf16* Y = tens == 0 ? LKT : LVT; LAS bf16* OUT = tens == 0 ? LWT : LUT;
        const bf16x8 a0 = *(const LAS bf16x8*)(T + (16 * ti + fr) * 72 + 8 * fq), a1 = *(const LAS bf16x8*)(T + (16 * ti + fr) * 72 + 32 + 8 * fq);
#pragma unroll
        for (int td = 0; td < 8; ++td) {
            f32x4 acc = {0.f, 0.f, 0.f, 0.f};
            const bf16x8 b0 = *(const LAS bf16x8*)(Y + (16 * td + fr) * 72 + 8 * fq), b1 = *(const LAS bf16x8*)(Y + (16 * td + fr) * 72 + 32 + 8 * fq);
            acc = mfma16(a0, b0, acc); acc = mfma16(a1, b1, acc);
            u32x2 o; o.x = pk(acc[0], acc[1]); o.y = pk(acc[2], acc[3]);
            *(LAS u32x2*)(OUT + (16 * td + fr) * 72 + 16 * ti + 4 * fq) = o;
        }
    }
    __syncthreads();
    {
        const int ta = wave;
        const bf16x8 kb0 = *(const LAS bf16x8*)(LKD + (16 * ta + fr) * 72 + 8 * fq), kb1 = *(const LAS bf16x8*)(LKD + (16 * ta + fr) * 72 + 32 + 8 * fq);
#pragma unroll
        for (int s = 0; s < 4; ++s) {
            f32x4 c0 = {0.f, 0.f, 0.f, 0.f}, c1 = {0.f, 0.f, 0.f, 0.f};
            const LAS bf16* w0p = LWT + (32 * s + fr) * 72 + 8 * fq; const LAS bf16* w1p = LWT + (32 * s + 16 + fr) * 72 + 8 * fq;
            c0 = mfma16(*(const LAS bf16x8*)w0p, kb0, c0); c0 = mfma16(*(const LAS bf16x8*)(w0p + 32), kb1, c0);
            c1 = mfma16(*(const LAS bf16x8*)w1p, kb0, c1); c1 = mfma16(*(const LAS bf16x8*)(w1p + 32), kb1, c1);
            u32x4 o; o.x = pk(-c0[0], -c0[1]); o.y = pk(-c0[2], -c0[3]); o.z = pk(-c1[0], -c1[1]); o.w = pk(-c1[2], -c1[3]);
            *(u32x4*)(R + REC_N + ((ta * 4 + s) * 64 + lane) * 8) = o;
        }
#pragma unroll
        for (int tv = 0; tv < 8; ++tv) {
            f32x4 c = {0.f, 0.f, 0.f, 0.f};
            const LAS bf16* up = LUT + (16 * tv + fr) * 72 + 8 * fq;
            c = mfma16(kb0, *(const LAS bf16x8*)up, c); c = mfma16(kb1, *(const LAS bf16x8*)(up + 32), c);
            u32x2 o; o.x = pk(c[0], c[1]); o.y = pk(c[2], c[3]);
            *(u32x2*)(R + REC_B + ((tv * 8 + ta) * 64 + lane) * 4) = o;
        }
    }
    {
        const int ti = wave & 3, hf = wave >> 2;
        const bf16x8 p0 = *(const LAS bf16x8*)(LP + (16 * ti + fr) * 72 + 8 * fq), p1 = *(const LAS bf16x8*)(LP + (16 * ti + fr) * 72 + 32 + 8 * fq);
        const int i = 16 * ti + fr; const float eg = SMG[192 + i];
#pragma unroll
        for (int s2 = 0; s2 < 2; ++s2) {
            const int s = 2 * hf + s2;
            f32x4 c0 = {0.f, 0.f, 0.f, 0.f}, c1 = {0.f, 0.f, 0.f, 0.f};
            const LAS bf16* w0p = LWT + (32 * s + fr) * 72 + 8 * fq; const LAS bf16* w1p = LWT + (32 * s + 16 + fr) * 72 + 8 * fq;
            c0 = mfma16(*(const LAS bf16x8*)w0p, p0, c0); c0 = mfma16(*(const LAS bf16x8*)(w0p + 32), p1, c0);
            c1 = mfma16(*(const LAS bf16x8*)w1p, p0, c1); c1 = mfma16(*(const LAS bf16x8*)(w1p + 32), p1, c1);
            const u32x2 q0 = *(const LAS u32x2*)(LQ + i * 136 + 32 * s + 4 * fq), q1 = *(const LAS u32x2*)(LQ + i * 136 + 32 * s + 16 + 4 * fq);
            u32x4 o; o.x = pk(eg * bf_lo(q0.x) - c0[0], eg * bf_hi(q0.x) - c0[1]); o.y = pk(eg * bf_lo(q0.y) - c0[2], eg * bf_hi(q0.y) - c0[3]);
            o.z = pk(eg * bf_lo(q1.x) - c1[0], eg * bf_hi(q1.x) - c1[1]); o.w = pk(eg * bf_lo(q1.y) - c1[2], eg * bf_hi(q1.y) - c1[3]);
            *(u32x4*)(R + REC_Q + ((ti * 4 + s) * 64 + lane) * 8) = o;
        }
#pragma unroll
        for (int t2 = 0; t2 < 4; ++t2) {
            const int tv = 4 * hf + t2;
            f32x4 c = {0.f, 0.f, 0.f, 0.f};
            const LAS bf16* up = LUT + (16 * tv + fr) * 72 + 8 * fq;
            c = mfma16(p0, *(const LAS bf16x8*)up, c); c = mfma16(p1, *(const LAS bf16x8*)(up + 32), c);
            u32x2 o; o.x = pk(c[0], c[1]); o.y = pk(c[2], c[3]);
            *(u32x2*)(R + REC_O + ((tv * 4 + ti) * 64 + lane) * 4) = o;
        }
    }
    __syncthreads();
}

DI void conv_rows16(f32x2 (&acc)[16], const f32x2 (&w)[31], const LAS unsigned* LT0, int tid) {
#pragma unroll
    for (int p = 0; p < 46; ++p) {
        const unsigned u = LT0[p * 512 + tid]; const float x0 = bf_lo(u), x1 = bf_hi(u);
#pragma unroll
        for (int t = 0; t < 16; ++t) { if (p - t >= 0 && p - t <= 30) { acc[t].x += w[p - t].x * x0; acc[t].y += w[p - t].y * x1; } }
    }
}
DI void p2_conf_item(const Ctx& C, int item, LAS unsigned char* lds_in) {
    LAS unsigned char* lds = opaque_lds(lds_in);
    const int tid = C.tid, lane = C.lane, wave = C.wave;
    const int b = item >> 6, t0 = (item & 63) * 32;
    LAS unsigned* LT = (LAS unsigned*)lds;
    LAS float* LPART = (LAS float*)(lds + 126976);
    LAS float* LSTAT = (LAS float*)(lds + 126976 + 2048);
    for (int q = tid; q < 62 * 128; q += 512) {
        const int rr = q >> 7, c16 = q & 127, p = t0 - 30 + rr;
        const int row = p >= 0 ? b * SEQ + p : (p >= -16 ? ROW_META + 16 + p : -1);
        u32x4 v = {0u, 0u, 0u, 0u};
        if (row >= 0) v = *(const u32x4*)(C.GLU + (size_t)row * 1024 + c16 * 8);
        *(LAS u32x4*)(lds + rr * 2048 + c16 * 16) = v;
    }
    __syncthreads();
    const int ch = 2 * tid;
    f32x2 w[31];
#pragma unroll
    for (int j = 0; j < 31; ++j) { unsigned o = ch + j * 1024; asm volatile("" : "+v"(o)); w[j] = *(const f32x2*)(C.cdw + o); }
    const f32x2 bias = *(const f32x2*)(C.cdb + ch);
    f32x2 acc[32];
    {
        f32x2 accA[16], accB[16];
#pragma unroll
        for (int t = 0; t < 16; ++t) { accA[t] = bias; accB[t] = bias; }
        conv_rows16(accA, w, LT, tid);
        conv_rows16(accB, w, LT + 16 * 512, tid);
#pragma unroll
        for (int t = 0; t < 16; ++t) { acc[t] = accA[t]; acc[16 + t] = accB[t]; }
    }
    float vals[64];
#pragma unroll
    for (int t = 0; t < 32; ++t) { vals[t] = acc[t].x + acc[t].y; vals[32 + t] = acc[t].x * acc[t].x + acc[t].y * acc[t].y; }
#define BFLY(off_, n_) { const bool up = (lane & off_) != 0; _Pragma("unroll") for (int i = 0; i < n_; ++i) { const float keep = up ? vals[i + n_] : vals[i]; const float send = up ? vals[i] : vals[i + n_]; vals[i] = keep + __shfl_xor(send, off_); } }
    BFLY(32, 32) BFLY(16, 16) BFLY(8, 8) BFLY(4, 4) BFLY(2, 2) BFLY(1, 1)
#undef BFLY
    LPART[wave * 64 + lane] = vals[0];
    __syncthreads();
    if (tid < 32) {
        float s1 = 0.f, s2 = 0.f;
#pragma unroll
        for (int wv = 0; wv < 8; ++wv) { s1 += LPART[wv * 64 + tid]; s2 += LPART[wv * 64 + 32 + tid]; }
        const float mean = s1 * (1.f / 1024.f); const float var = fmaxf(s2 * (1.f / 1024.f) - mean * mean, 0.f);
        LSTAT[2 * tid] = mean; LSTAT[2 * tid + 1] = rsqrtf(var + LN_EPS);
    }
    __syncthreads();
    const f32x2 lw = *(const f32x2*)(C.clw + ch), lb = *(const f32x2*)(C.clb + ch);
#pragma unroll
    for (int t = 0; t < 32; ++t) {
        const float mean = LSTAT[2 * t], rstd = LSTAT[2 * t + 1]; const size_t row = (size_t)b * SEQ + t0 + t;
        unsigned oz = (unsigned)row * 1024 + ch, oa = (unsigned)row * 2048 + 1024 + ch; asm volatile("" : "+v"(oz), "+v"(oa));
        const unsigned z = *(const unsigned*)(C.ZC + oz);
        const float y0 = (acc[t].x - mean) * rstd * lw.x + lb.x, y1 = (acc[t].y - mean) * rstd * lw.y + lb.y;
        *(unsigned*)(C.A2 + oa) = pk(silu(y0) * bf_lo(z), silu(y1) * bf_hi(z));
    }
    if (t0 == SEQ - 32) {
#pragma unroll 2
        for (int rr = 32; rr < 62; ++rr) { const unsigned u = LT[rr * 512 + tid]; f32x2 o; o.x = bf_lo(u); o.y = bf_hi(u);
            *(f32x2*)(C.out + O_CP + ((size_t)b * 30 + rr - 32) * 1024 + ch) = o; }
    }
    __syncthreads();
}

DI void p2_sgdn_item(const Ctx& C, int item, LAS unsigned char* lds) {
    const int tid = C.tid, lane = C.lane, wave = C.wave;
    const int s = item >> 3, h = item & 7, row = ROW_SAMP + s;
    LAS float* Lq = (LAS float*)lds; LAS float* Lk = Lq + 128; LAS float* Lv = Lq + 256; LAS float* Lsc = Lq + 384; LAS float* Lvn = Lq + 400; LAS float* Lo = Lq + 528;
    LAS float* LrK = (LAS float*)(lds + 4096); LAS float* LrQ = (LAS float*)(lds + 4096 + 8192);
    if (tid < 384) {
        const int z = tid >> 7, d = tid & 127, col = z * 1024 + h * 128 + d;
        const float* hs = C.sgc + (size_t)s * 3 * 3072 + col;
        const float h0 = hs[0], h1 = hs[3072], h2 = hs[6144], cur = bf2f(C.QKV[(size_t)row * 3072 + col]);
        const float x = C.gcw[col] * h0 + C.gcw[3072 + col] * h1 + C.gcw[6144 + col] * h2 + C.gcw[9216 + col] * cur;
        Lq[z * 128 + d] = silu(x);
        float* og = C.out + O_GS + (size_t)s * 3 * 3072 + col; og[0] = h1; og[3072] = h2; og[6144] = cur;
    }
    __syncthreads();
    if (wave == 0) {
        float q0 = Lq[lane], q1 = Lq[64 + lane], k0 = Lk[lane], k1 = Lk[64 + lane];
        const float scq = rsqrtf(wave_sum(q0 * q0 + q1 * q1) + RMS_EPS) * 0.08838834764831845f, sck = rsqrtf(wave_sum(k0 * k0 + k1 * k1) + RMS_EPS);
        q0 *= scq; q1 *= scq; k0 *= sck; k1 *= sck;
        Lq[lane] = q0; Lq[64 + lane] = q1; Lk[lane] = k0; Lk[64 + lane] = k1;
        const float qk = wave_sum(q0 * k0 + q1 * k1);
        if (lane == 0) { const float al = C.AB[(size_t)row * 16 + h], br = C.AB[(size_t)row * 16 + 8 + h];
            const float x = al + C.dtb[h]; const float sp = x > 20.f ? x : log1pf(__expf(x));
            Lsc[0] = __expf(-__expf(C.alog[h]) * sp); Lsc[1] = sigm(br); Lsc[2] = qk; }
    }
    __syncthreads();
    const float eg = Lsc[0], be = Lsc[1], qk = Lsc[2];
    const int v4 = (tid & 31) * 4, a0 = tid >> 5;
    const float* Sg = C.sS + (size_t)(s * 8 + h) * 16384;
    f32x4 Sv[8]; f32x4 ks = {0.f, 0.f, 0.f, 0.f}, qs = {0.f, 0.f, 0.f, 0.f};
#pragma unroll
    for (int i = 0; i < 8; ++i) { const int a = a0 + 16 * i; Sv[i] = *(const f32x4*)(Sg + a * 128 + v4); ks += Lk[a] * Sv[i]; qs += Lq[a] * Sv[i]; }
    *(LAS f32x4*)(LrK + a0 * 128 + v4) = ks; *(LAS f32x4*)(LrQ + a0 * 128 + v4) = qs;
    __syncthreads();
    if (tid < 128) {
        float kS = 0.f, qS = 0.f;
#pragma unroll
        for (int r = 0; r < 16; ++r) { kS += LrK[r * 128 + tid]; qS += LrQ[r * 128 + tid]; }
        const float vn = be * (Lv[tid] - eg * kS);
        Lvn[tid] = vn; Lo[tid] = eg * qS + qk * vn;
    }
    __syncthreads();
    const f32x4 vn4 = *(const LAS f32x4*)(Lvn + v4);
    float* So = C.out + O_SS + (size_t)(s * 8 + h) * 16384;
#pragma unroll
    for (int i = 0; i < 8; ++i) { const int a = a0 + 16 * i; *(f32x4*)(So + a * 128 + v4) = eg * Sv[i] + Lk[a] * vn4; }
    if (wave == 0) {
        const float o0 = Lo[lane], o1 = Lo[64 + lane];
        const float rstd = rsqrtf(wave_sum(o0 * o0 + o1 * o1) * (1.f / 128.f) + RMS_EPS);
        const bf16* zg = C.ZG + (size_t)row * 1024 + h * 128; bf16* ao = C.A2 + (size_t)(8192 + s) * 2048 + h * 128;
        ao[lane] = f2b(o0 * rstd * C.gnw[lane] * bf2f(zg[lane])); ao[64 + lane] = f2b(o1 * rstd * C.gnw[64 + lane] * bf2f(zg[64 + lane]));
    }
    __syncthreads();
}
DI void p2_sconf_item(const Ctx& C, int s, LAS unsigned char* lds) {
    const int tid = C.tid, lane = C.lane, wave = C.wave;
    const int ch = 2 * tid, row = ROW_SAMP + s;
    LAS float* Lp = (LAS float*)lds;
    const float* hs = C.scc + (size_t)s * 30 * 1024 + ch; float* oc = C.out + O_CS + (size_t)s * 30 * 1024 + ch;
    f32x2 acc = *(const f32x2*)(C.cdb + ch);
#pragma unroll 6
    for (int j = 0; j < 30; ++j) { const f32x2 hv = *(const f32x2*)(hs + j * 1024); const f32x2 wj = *(const f32x2*)(C.cdw + j * 1024 + ch); acc += wj * hv; if (j >= 1) *(f32x2*)(oc + (j - 1) * 1024) = hv; }
    const unsigned gu = *(const unsigned*)(C.GLU + (size_t)row * 1024 + ch); f32x2 gv; gv.x = bf_lo(gu); gv.y = bf_hi(gu);
    acc += *(const f32x2*)(C.cdw + 30 * 1024 + ch) * gv; *(f32x2*)(oc + 29 * 1024) = gv;
    const float s1 = wave_sum(acc.x + acc.y), s2 = wave_sum(acc.x * acc.x + acc.y * acc.y);
    if (lane == 0) { Lp[wave * 2] = s1; Lp[wave * 2 + 1] = s2; }
    __syncthreads();
    float t1 = 0.f, t2 = 0.f;
#pragma unroll
    for (int wv = 0; wv < 8; ++wv) { t1 += Lp[wv * 2]; t2 += Lp[wv * 2 + 1]; }
    const float mean = t1 * (1.f / 1024.f), rstd = rsqrtf(fmaxf(t2 * (1.f / 1024.f) - mean * mean, 0.f) + LN_EPS);
    const f32x2 lw = *(const f32x2*)(C.clw + ch), lb = *(const f32x2*)(C.clb + ch);
    const unsigned z = *(const unsigned*)(C.ZC + (size_t)row * 1024 + ch);
    const float y0 = (acc.x - mean) * rstd * lw.x + lb.x, y1 = (acc.y - mean) * rstd * lw.y + lb.y;
    *(unsigned*)(C.A2 + (size_t)(8192 + s) * 2048 + 1024 + ch) = pk(silu(y0) * bf_lo(z), silu(y1) * bf_hi(z));
    __syncthreads();
}
DI void p2_misc_item(const Ctx& C) {
    for (int i = C.tid; i < NB * 3 * 3072; i += 512) { const int col = i % 3072, j = (i / 3072) % 3, b = i / 9216;
        C.out[O_GP + i] = bf2f(C.QKV[(size_t)(b * SEQ + SEQ - 3 + j) * 3072 + col]); }
}
DI void p2_phase(const Ctx& C, LAS unsigned char* lds) {
#ifndef DBG_P2
#define DBG_P2 31
#endif
    if (DBG_P2 & 1) for (int it = C.vcu; it < NREC; it += C.G) p2_gdn_item(C, it, lds);
    if (DBG_P2 & 2) for (int it = C.vcu; it < NB * 64; it += C.G) p2_conf_item(C, it, lds);
    if (DBG_P2 & 4) for (int it = C.vcu; it < NS * NH; it += C.G) p2_sgdn_item(C, it, lds);
    if (DBG_P2 & 8) for (int it = C.G - 1 - C.vcu; it < NS; it += C.G) p2_sconf_item(C, it, lds);
    if (DBG_P2 & 16) if (C.vcu == C.G / 2) p2_misc_item(C);
}

DI const bf16* rec_ptr(const Ctx& C, int b, int h, int c) { const int rec = c == 0 ? h : 8 + ((b * 32 + c - 1) * 8 + h); return C.REC + (size_t)rec * REC_ELEMS; }
DI void p3_scan(const Ctx& C, int bh, LAS unsigned char* lds) {
    const int tid = C.tid, lane = C.lane, wave = C.wave, fr = lane & 15, fq = lane >> 4;
    const int b = bh >> 3, h = bh & 7, tv = wave;
    LAS float* Lo = (LAS float*)(lds + 98304);
    f32x4 S[8]; bf16x8 Sb[4];
#pragma unroll
    for (int i = 0; i < 8; ++i) S[i] = (f32x4){0.f, 0.f, 0.f, 0.f};
#pragma unroll
    for (int i = 0; i < 4; ++i) Sb[i] = (bf16x8){0, 0, 0, 0, 0, 0, 0, 0};
#define SCAN_DMA(c_, buf_) do { const bf16* src_ = rec_ptr(C, b, h, (c_)); _Pragma("unroll") for (int i_ = 0; i_ < 6; ++i_) { const int p_ = wave * 6 + i_; \
        __builtin_amdgcn_global_load_lds((const unsigned*)(src_ + p_ * 512 + lane * 8), (LAS unsigned*)(lds + (buf_) * 49152 + p_ * 1024), 16, 0, 0); } } while (0)
    u32x2 nB[8], nO[4];
    {
        const bf16* r0 = rec_ptr(C, b, h, 0);
        SCAN_DMA(0, 0);
#pragma unroll
        for (int ta = 0; ta < 8; ++ta) nB[ta] = *(const u32x2*)(r0 + REC_B + ((tv * 8 + ta) * 64 + lane) * 4);
#pragma unroll
        for (int ti = 0; ti < 4; ++ti) nO[ti] = *(const u32x2*)(r0 + REC_O + ((tv * 4 + ti) * 64 + lane) * 4);
    }
    for (int c = 0; c < 33; ++c) {
        __syncthreads();
        u32x2 cB[8], cO[4];
#pragma unroll
        for (int ta = 0; ta < 8; ++ta) cB[ta] = nB[ta];
#pragma unroll
        for (int ti = 0; ti < 4; ++ti) cO[ti] = nO[ti];
        const float dec = C.DEC[c == 0 ? h : 8 + ((b * 32 + c - 1) * 8 + h)];
        if (c + 1 < 33) {
            const bf16* r1 = rec_ptr(C, b, h, c + 1);
            SCAN_DMA(c + 1, (c + 1) & 1);
#pragma unroll
            for (int ta = 0; ta < 8; ++ta) nB[ta] = *(const u32x2*)(r1 + REC_B + ((tv * 8 + ta) * 64 + lane) * 4);
#pragma unroll
            for (int ti = 0; ti < 4; ++ti) nO[ti] = *(const u32x2*)(r1 + REC_O + ((tv * 4 + ti) * 64 + lane) * 4);
        }
        const LAS bf16* F = (const LAS bf16*)(lds + (c & 1) * 49152);
        if (c >= 1) {
#pragma unroll
            for (int ti = 0; ti < 4; ++ti) {
                f32x4 acc = {bf_lo(cO[ti].x), bf_hi(cO[ti].x), bf_lo(cO[ti].y), bf_hi(cO[ti].y)};
#pragma unroll
                for (int s = 0; s < 4; ++s) acc = mfma16(*(const LAS bf16x8*)(F + REC_Q + ((ti * 4 + s) * 64 + lane) * 8), Sb[s], acc);
#pragma unroll
                for (int r = 0; r < 4; ++r) Lo[(16 * ti + 4 * fq + r) * 132 + 16 * tv + fr] = acc[r];
            }
        }
#pragma unroll
        for (int ta = 0; ta < 8; ++ta) {
            f32x4 acc = dec * S[ta] + (f32x4){bf_lo(cB[ta].x), bf_hi(cB[ta].x), bf_lo(cB[ta].y), bf_hi(cB[ta].y)};
#pragma unroll
            for (int s = 0; s < 4; ++s) acc = mfma16(*(const LAS bf16x8*)(F + REC_N + ((ta * 4 + s) * 64 + lane) * 8), Sb[s], acc);
            S[ta] = acc;
        }
#pragma unroll
        for (int s = 0; s < 4; ++s) {
            u32x4 p; p.x = pk(S[2 * s][0], S[2 * s][1]); p.y = pk(S[2 * s][2], S[2 * s][3]); p.z = pk(S[2 * s + 1][0], S[2 * s + 1][1]); p.w = pk(S[2 * s + 1][2], S[2 * s + 1][3]);
            Sb[s] = __builtin_bit_cast(bf16x8, p);
        }
        __syncthreads();
        if (c >= 1) {
            const int row = tid >> 3, cb = (tid & 7) * 16; const LAS float* lo = Lo + row * 132 + cb;
            const f32x4 x0 = *(const LAS f32x4*)lo, x1 = *(const LAS f32x4*)(lo + 4), x2 = *(const LAS f32x4*)(lo + 8), x3 = *(const LAS f32x4*)(lo + 12);
            float ss = dot4(x0) + dot4(x1) + dot4(x2) + dot4(x3);
            ss += __shfl_xor(ss, 1); ss += __shfl_xor(ss, 2); ss += __shfl_xor(ss, 4);
            const float rstd = rsqrtf(ss * (1.f / 128.f) + RMS_EPS);
            const size_t grow = (size_t)b * SEQ + (c - 1) * 64 + row;
            const u32x4 z0 = *(const u32x4*)(C.ZG + grow * 1024 + h * 128 + cb), z1 = *(const u32x4*)(C.ZG + grow * 1024 + h * 128 + cb + 8);
            const f32x4 w0 = *(const f32x4*)(C.gnw + cb), w1 = *(const f32x4*)(C.gnw + cb + 4), w2 = *(const f32x4*)(C.gnw + cb + 8), w3 = *(const f32x4*)(C.gnw + cb + 12);
            u32x4 o0, o1;
            o0.x = pk(x0.x * rstd * w0.x * bf_lo(z0.x), x0.y * rstd * w0.y * bf_hi(z0.x)); o0.y = pk(x0.z * rstd * w0.z * bf_lo(z0.y), x0.w * rstd * w0.w * bf_hi(z0.y));
            o0.z = pk(x1.x * rstd * w1.x * bf_lo(z0.z), x1.y * rstd * w1.y * bf_hi(z0.z)); o0.w = pk(x1.z * rstd * w1.z * bf_lo(z0.w), x1.w * rstd * w1.w * bf_hi(z0.w));
            o1.x = pk(x2.x * rstd * w2.x * bf_lo(z1.x), x2.y * rstd * w2.y * bf_hi(z1.x)); o1.y = pk(x2.z * rstd * w2.z * bf_lo(z1.y), x2.w * rstd * w2.w * bf_hi(z1.y));
            o1.z = pk(x3.x * rstd * w3.x * bf_lo(z1.z), x3.y * rstd * w3.y * bf_hi(z1.z)); o1.w = pk(x3.z * rstd * w3.z * bf_lo(z1.w), x3.w * rstd * w3.w * bf_hi(z1.w));
            *(u32x4*)(C.A2 + grow * 2048 + h * 128 + cb) = o0; *(u32x4*)(C.A2 + grow * 2048 + h * 128 + cb + 8) = o1;
        }
    }
#undef SCAN_DMA
    float* so = C.out + O_SP + (size_t)(b * 8 + h) * 16384;
#pragma unroll
    for (int ta = 0; ta < 8; ++ta)
#pragma unroll
        for (int r = 0; r < 4; ++r) so[(16 * ta + 4 * fq + r) * 128 + 16 * tv + fr] = S[ta][r];
    __syncthreads();
}

DI void p5_final(const Ctx& C) {
    const int gw = C.vcu * NWAVES + C.wave, NGW = C.G * NWAVES;
    for (int m = gw; m < ROWS2; m += NGW) {
        float* orow = m < 8192 ? C.out + O_Y + (size_t)m * DM : C.out + O_YS + (size_t)(m - 8192) * DM;
        const float rs = rsqrtf(C.ROWSS[m] * (1.f / DM) + RMS_EPS);
#pragma unroll
        for (int j = 0; j < 8; ++j) { const f32x4 v = *(const f32x4*)(orow + 4 * C.lane + 256 * j); const f32x4 w = *(const f32x4*)(C.fnw + 4 * C.lane + 256 * j);
            *(f32x4*)(orow + 4 * C.lane + 256 * j) = v * rs * w; }
    }
}

struct Args { const float* in[18]; float* out; unsigned char* ws; int ph_lo, ph_hi; };
__global__ void __launch_bounds__(NWAVES * 64, 2) mk_fwd(Args args) {
    extern __shared__ __attribute__((aligned(16))) unsigned char lds_raw[];
    LAS unsigned char* lds = (LAS unsigned char*)lds_raw;
    Ctx C;
    C.tid = threadIdx.x; C.lane = C.tid & 63; C.wave = __builtin_amdgcn_readfirstlane(C.tid >> 6);
    C.G = gridDim.x; C.bx = blockIdx.x; C.vcu = (C.G % 8 == 0) ? (C.bx % 8) * (C.G / 8) + C.bx / 8 : C.bx;
    C.xp = args.in[0]; C.xs = args.in[1]; C.sS = args.in[2]; C.sgc = args.in[3]; C.scc = args.in[4]; C.meta = args.in[5]; C.normw = args.in[6]; C.win = args.in[7];
    C.gcw = args.in[8]; C.alog = args.in[9]; C.dtb = args.in[10]; C.gnw = args.in[11]; C.cdw = args.in[12]; C.cdb = args.in[13]; C.clw = args.in[14]; C.clb = args.in[15];
    C.wout = args.in[16]; C.fnw = args.in[17]; C.out = args.out;
    unsigned char* ws = args.ws;
    C.ctl = (gu32*)(ws + WS_CTL); C.AB = (float*)(ws + WS_AB); C.ROWSS = (float*)(ws + WS_ROWSS); C.DEC = (float*)(ws + WS_DEC);
    C.WT1 = (bf16*)(ws + WS_WT1); C.WT2 = (bf16*)(ws + WS_WT2); C.XN = (bf16*)(ws + WS_XN); C.QKV = (bf16*)(ws + WS_QKV); C.ZG = (bf16*)(ws + WS_ZG);
    C.GLU = (bf16*)(ws + WS_GLU); C.ZC = (bf16*)(ws + WS_ZC); C.A2 = (bf16*)(ws + WS_A2); C.REC = (bf16*)(ws + WS_REC);
    for (int u = C.tid; u < (LDS_BYTES - LDSCTL_OFF) / 4; u += NWAVES * 64) ((LAS unsigned*)(lds + LDSCTL_OFF))[u] = 0u;
    __syncthreads();
#ifdef DBG_LO
    const int lo = DBG_LO, hi = DBG_HI;
#else
    const int lo = args.ph_lo, hi = args.ph_hi;
#endif
    XcdBarrier bar; bar.bar = (unsigned*)(C.ctl + CW_BAR); bar.x = 0; bar.st = nullptr;
    if (hi - lo > 1) bar = xcd_barrier_post((unsigned*)(C.ctl + CW_BAR), (volatile LAS unsigned*)(lds + MISC_OFF) + 8);
#define IN(k) (lo <= (k) && (k) < hi)
#define SEAM(k) do { if (IN(k) && IN((k) + 1)) xcd_barrier(bar); } while (0)
    if (IN(0)) { p0_prologue(C, lds); }
    SEAM(0);
    if (IN(1)) {
        pg8::Gemm g{C.XN, C.WT1, M1, N1, DM}; pg8::StaticOrder S; S.init(M1, N1, C.G, C.bx);
        EpiP1 E{C.QKV, C.ZG, C.GLU, C.ZC, C.AB};
        pg8::gemm_phase<EpiP1, pg8::StaticOrder, true, true>(lds, g, S, E);
    }
    SEAM(1);
    if (IN(2)) { p2_phase(C, lds); }
    SEAM(2);
    if (IN(3)) {
        if (C.bx < 32) p3_scan(C, C.bx, lds);
        else if (C.bx < 40 && !DBG_NOSG) {
            pg8::Gemm g{C.A2 + (size_t)8192 * 2048, C.WT2, 256, DM, DM}; pg8::StaticOrder S; S.init(256, DM, 8, C.bx - 32);
            EpiRes E{C.xp, C.xs, C.out, C.ROWSS, 8192};
            pg8::gemm_phase<EpiRes, pg8::StaticOrder, false, true>(lds, g, S, E);
        }
    }
    SEAM(3);
    if (IN(4)) {
        pg8::Gemm g{C.A2, C.WT2, 8192, DM, DM}; pg8::StaticOrder S; S.init(8192, DM, C.G, C.bx);
        EpiRes E{C.xp, C.xs, C.out, C.ROWSS, 0};
        pg8::gemm_phase<EpiRes, pg8::StaticOrder, false, true>(lds, g, S, E);
    }
    SEAM(4);
    if (IN(5)) { p5_final(C); }
#undef IN
#undef SEAM
}

extern "C" void kernel_launch(void* const* d_in, const int* in_sizes, int n_in, void* d_out, int out_size, void* d_ws, size_t ws_size, hipStream_t stream) {
    static int grid = 0;
    if (grid == 0) {
        if (n_in != 18 || out_size != (int)O_END || ws_size < WS_END) { fprintf(stderr, "kernel_launch: unexpected shapes (n_in %d, out %d, ws %zu); nothing launched\n", n_in, out_size, ws_size); grid = -1; return; }
        int dev = 0, cus = 0, per_cu = 0;
        if (hipGetDevice(&dev) != hipSuccess || hipDeviceGetAttribute(&cus, hipDeviceAttributeMultiprocessorCount, dev) != hipSuccess) { fprintf(stderr, "kernel_launch: device query failed\n"); grid = -1; return; }
        if (hipFuncSetAttribute((const void*)mk_fwd, hipFuncAttributeMaxDynamicSharedMemorySize, LDS_BYTES) != hipSuccess) { fprintf(stderr, "kernel_launch: hipFuncSetAttribute failed\n"); grid = -1; return; }
        if (hipOccupancyMaxActiveBlocksPerMultiprocessor(&per_cu, (const void*)mk_fwd, NWAVES * 64, LDS_BYTES) != hipSuccess || per_cu < 1) { fprintf(stderr, "kernel_launch: occupancy query reports %d workgroups per CU\n", per_cu); }
        (void)hipGetLastError();
        grid = cus;
        if (grid < 40) { fprintf(stderr, "kernel_launch: needs >= 40 CUs\n"); grid = -1; return; }
    }
    if (grid < 0) return;
    (void)hipMemsetAsync((char*)d_ws + WS_CTL, 0, CTL_ZERO_BYTES, stream);
#ifdef DBG_ZERO_OUT
    (void)hipMemsetAsync(d_out, 0, (size_t)DBG_ZERO_OUT * 4, stream);
#endif
    Args a{};
    for (int i = 0; i < 18; ++i) a.in[i] = (const float*)d_in[i];
    a.out = (float*)d_out; a.ws = (unsigned char*)d_ws;
#if MK_N_LAUNCHES == 1
    a.ph_lo = 0; a.ph_hi = NPHASE;
    hipLaunchKernelGGL(mk_fwd, dim3(grid), dim3(NWAVES * 64), LDS_BYTES, stream, a);
#else
#ifndef DBG_MAXPH
#define DBG_MAXPH NPHASE
#endif
    for (int p = 0; p < DBG_MAXPH; ++p) { a.ph_lo = p; a.ph_hi = p + 1; hipLaunchKernelGGL(mk_fwd, dim3(grid), dim3(NWAVES * 64), LDS_BYTES, stream, a); }
#endif
}
```

```cpp
#include <hip/hip_runtime.h>
#include <cstdio>
#include <cstdint>
namespace pg8 {
#define PG8_LAS __attribute__((address_space(3)))
typedef unsigned short bf16_t;
typedef short bf16x8 __attribute__((ext_vector_type(8)));
typedef float f32x4 __attribute__((ext_vector_type(4)));
typedef unsigned u32x4 __attribute__((ext_vector_type(4)));
constexpr int BM = 256, BK = 64, HALF = 128, HTB = HALF * BK * 2  , STAGE_BYTES = 8 * HTB, NXCD = 8, WGM = 8;

__host__ __device__ __forceinline__ int lds_byte(int r, int c) { const int st = (r >> 4) * 2 + (c >> 5), rr = r & 15, cc = c & 31, ob = rr * 64 + cc * 2; return st * 1024 + (ob ^ (((ob >> 9) & 1) << 5)); }
__host__ __device__ __forceinline__ void stage_rc(int b, int& R, int& C) { const int st = b / 1024, sb = b % 1024, swz = sb ^ (((sb >> 9) & 1) << 5); R = (st >> 1) * 16 + swz / 64; C = (st & 1) * 32 + (swz % 64) / 2; }
__host__ __device__ __forceinline__ int perm32(int rho) { const int n = rho >> 4, i = rho & 15; return 8 * (i >> 2) + 4 * n + (i & 3); }

struct Unit { int pm, pn; };
struct Gemm { const bf16_t* A; const bf16_t* Bt; int M, N, K; };

struct StaticOrder {
    int nM, nN, nwg, G, c;
    __host__ __device__ void init(int M, int N, int G_, int c_) { nM = M / BM; nN = N / BM; nwg = nM * nN; G = G_; c = c_; }
    __host__ __device__ bool next(int i, Unit& u) const {
        const long L = (long)i * G + c; if (L >= nwg) return false;
        int wgid = (int)L; { const int q = nwg / NXCD, r = nwg % NXCD, xcd = wgid % NXCD, off = wgid / NXCD; wgid = (xcd < r ? xcd * (q + 1) : r * (q + 1) + (xcd - r) * q) + off; }
        const int nig = WGM * nN, gid = wgid / nig, fm = gid * WGM, gsz = (nM - fm) < WGM ? (nM - fm) : WGM;
        u.pm = fm + ((wgid % nig) % gsz); u.pn = (wgid % nig) / gsz; return true;
    }
    __device__ __forceinline__ void a_ready(const Unit&) const {}
    __device__ __forceinline__ void done(const Unit&) const {}
};

__device__ __forceinline__ unsigned cvt_pk_bf16(float lo, float hi) { unsigned r; asm volatile("v_cvt_pk_bf16_f32 %0, %1, %2" : "=v"(r) : "v"(lo), "v"(hi)); return r; }
template <class Epi, class Sched, bool ALIGN_EPI = false, bool SP2 = false>
__device__ __forceinline__ void gemm_phase(PG8_LAS unsigned char* lds, const Gemm g, const Sched& S, const Epi& E) {
    const int tid = threadIdx.x, wid = __builtin_amdgcn_readfirstlane(tid >> 6), lane = tid & 63, wr = wid >> 2, wc = wid & 3, fr = lane & 15, fq = lane >> 4;
    const int K = g.K, nt = K / BK;
    unsigned voffA[2], voffB[2];
#pragma unroll
    for (int i = 0; i < 2; ++i) { int R, C; stage_rc(tid * 16 + i * 8192, R, C); const int Rb = Epi::PERM ? ((R & ~31) + perm32(R & 31)) : R;
        voffA[i] = (unsigned)(R * K + C) * 2u; voffB[i] = (unsigned)(Rb * K + C) * 2u; }
    const size_t kstep = (size_t)(BK * 2);
    const size_t hstep = (size_t)HALF * K * 2;
    const size_t tstep = 2 * hstep;
    const unsigned ldsw = (unsigned)wid * 1024u;
    const int aoff = lds_byte(wr * 64 + fr, fq * 8), boff = lds_byte(wc * 32 + fr, fq * 8);
#define PG8_SA(b, h) (((b) * 2 + (h)) * HTB)
#define PG8_SB(b, h) ((4 + (b) * 2 + (h)) * HTB)
#define PG8_STAGE(bufoff, gbase, voff) do { _Pragma("unroll") for (int _i = 0; _i < 2; ++_i) \
        __builtin_amdgcn_global_load_lds((const unsigned*)((const char*)(gbase) + (voff)[_i]), (PG8_LAS unsigned*)(lds + (bufoff) + ldsw + _i * 8192), 16, 0, 0); } while (0)
#define PG8_LDA(dst, b, h) do { _Pragma("unroll") for (int m = 0; m < 4; ++m) _Pragma("unroll") for (int k = 0; k < 2; ++k) dst[m][k] = *(const PG8_LAS bf16x8*)(lds + PG8_SA(b, h) + aoff + m * 2048 + k * 1024); } while (0)
#define PG8_LDB(dst, b, h) do { _Pragma("unroll") for (int n = 0; n < 2; ++n) _Pragma("unroll") for (int k = 0; k < 2; ++k) dst[n][k] = *(const PG8_LAS bf16x8*)(lds + PG8_SB(b, h) + boff + n * 2048 + k * 1024); } while (0)
#define PG8_MMA(ai, bj, At, Bt) do { __builtin_amdgcn_s_setprio(1); _Pragma("unroll") for (int m = 0; m < 4; ++m) _Pragma("unroll") for (int n = 0; n < 2; ++n) _Pragma("unroll") for (int k = 0; k < 2; ++k) \
        acc[ai][bj][m][n] = __builtin_amdgcn_mfma_f32_16x16x32_bf16(Bt[n][k], At[m][k], acc[ai][bj][m][n], 0, 0, 0); __builtin_amdgcn_s_setprio(0); } while (0)
#define PG8_WAIT_V(n) asm volatile("s_waitcnt vmcnt(" #n ")" ::: "memory")
#define PG8_WAIT_L(n) asm volatile("s_waitcnt lgkmcnt(" #n ")" ::: "memory")
#define PG8_BAR __builtin_amdgcn_s_barrier()
#define PG8_SCHED __builtin_amdgcn_sched_barrier(0)
    Unit cur, nxt; int ui = 0;
    if (!S.next(0, cur)) return;
    f32x4 acc[2][2][4][2];
#pragma unroll
    for (int a = 0; a < 2; ++a)
#pragma unroll
        for (int b = 0; b < 2; ++b)
#pragma unroll
            for (int m = 0; m < 4; ++m)
#pragma unroll
                for (int n = 0; n < 2; ++n) acc[a][b][m][n] = (f32x4){0.f, 0.f, 0.f, 0.f};
    bf16x8 At[4][2], B0[2][2], B1[2][2];
    const char* cA = (const char*)g.A + (size_t)cur.pm * tstep; const char* cB = (const char*)g.Bt + (size_t)cur.pn * tstep;
    S.a_ready(cur);
    if constexpr (SP2) {
        PG8_STAGE(PG8_SB(0, 0), cB, voffB); PG8_STAGE(PG8_SB(0, 1), cB + hstep, voffB); PG8_STAGE(PG8_SA(0, 0), cA, voffA); PG8_STAGE(PG8_SA(0, 1), cA + hstep, voffA);
        if (wr == 1) PG8_BAR;
        PG8_WAIT_V(2); PG8_BAR;
        PG8_STAGE(PG8_SB(1, 0), cB + kstep, voffB); PG8_STAGE(PG8_SA(1, 0), cA + kstep, voffA); PG8_STAGE(PG8_SB(1, 1), cB + hstep + kstep, voffB);
        PG8_WAIT_V(6); PG8_BAR;
    } else {
        PG8_STAGE(PG8_SB(0, 0), cB, voffB); PG8_STAGE(PG8_SA(0, 0), cA, voffA); PG8_STAGE(PG8_SB(0, 1), cB + hstep, voffB); PG8_STAGE(PG8_SA(0, 1), cA + hstep, voffA);
        if (wr == 1) PG8_BAR;
        PG8_WAIT_V(4); PG8_BAR;
        PG8_STAGE(PG8_SB(1, 0), cB + kstep, voffB); PG8_STAGE(PG8_SA(1, 0), cA + kstep, voffA); PG8_STAGE(PG8_SB(1, 1), cB + hstep + kstep, voffB);
        PG8_WAIT_V(6); PG8_BAR;
    }
    for (;;) {
        const bool has_next = S.next(ui + 1, nxt);
        const char* nA = has_next ? (const char*)g.A + (size_t)nxt.pm * tstep : cA; const char* nB = has_next ? (const char*)g.Bt + (size_t)nxt.pn * tstep : cB;
        for (int t = 0; t < nt; t += 2) {
            const bool last = (t == nt - 2);
            const char* a1 = cA + (size_t)(t + 1) * kstep;
            const char* a2 = last ? nA : cA + (size_t)(t + 2) * kstep; const char* b2 = last ? nB : cB + (size_t)(t + 2) * kstep;
            const char* a3 = a2 + kstep; const char* b3 = b2 + kstep;
            if (last && has_next) S.a_ready(nxt);
            if constexpr (SP2) {
            PG8_LDB(B0, 0, 0); PG8_LDB(B1, 0, 1); PG8_SCHED; PG8_LDA(At, 0, 0); PG8_STAGE(PG8_SA(1, 1), a1 + hstep, voffA);
            PG8_WAIT_V(8); PG8_WAIT_L(0); PG8_BAR; PG8_MMA(0, 0, At, B0); PG8_MMA(0, 1, At, B1); PG8_BAR; PG8_SCHED;
            PG8_LDA(At, 0, 1); PG8_STAGE(PG8_SB(0, 0), b2, voffB); PG8_STAGE(PG8_SB(0, 1), b2 + hstep, voffB); PG8_STAGE(PG8_SA(0, 0), a2, voffA);
            PG8_WAIT_V(8); PG8_WAIT_L(0); PG8_BAR; PG8_MMA(1, 0, At, B0); PG8_MMA(1, 1, At, B1); PG8_BAR; PG8_SCHED;
            PG8_LDB(B0, 1, 0); PG8_LDB(B1, 1, 1); PG8_SCHED; PG8_LDA(At, 1, 0); PG8_STAGE(PG8_SA(0, 1), a2 + hstep, voffA);
            PG8_WAIT_V(8); PG8_WAIT_L(0); PG8_BAR; PG8_MMA(0, 0, At, B0); PG8_MMA(0, 1, At, B1); PG8_BAR; PG8_SCHED;
            PG8_LDA(At, 1, 1); PG8_STAGE(PG8_SB(1, 0), b3, voffB); PG8_STAGE(PG8_SB(1, 1), b3 + hstep, voffB); PG8_STAGE(PG8_SA(1, 0), a3, voffA);
            PG8_WAIT_V(8); PG8_WAIT_L(0); PG8_BAR; PG8_MMA(1, 0, At, B0); PG8_MMA(1, 1, At, B1); PG8_BAR; PG8_SCHED;
            } else {
            PG8_LDB(B0, 0, 0); PG8_SCHED; PG8_LDA(At, 0, 0); PG8_STAGE(PG8_SA(1, 1), a1 + hstep, voffA);
            PG8_WAIT_L(8); PG8_BAR; PG8_WAIT_L(0); PG8_MMA(0, 0, At, B0); PG8_BAR; PG8_SCHED;
            PG8_LDB(B1, 0, 1); PG8_STAGE(PG8_SB(0, 0), b2, voffB);
            PG8_BAR; PG8_WAIT_L(0); PG8_MMA(0, 1, At, B1); PG8_BAR;
            PG8_LDA(At, 0, 1); PG8_STAGE(PG8_SA(0, 0), a2, voffA);
            PG8_BAR; PG8_WAIT_L(0); PG8_MMA(1, 0, At, B0); PG8_BAR; PG8_SCHED;
            PG8_STAGE(PG8_SB(0, 1), b2 + hstep, voffB);
            PG8_WAIT_V(6); PG8_BAR; PG8_MMA(1, 1, At, B1); PG8_BAR;
            PG8_LDB(B0, 1, 0); PG8_SCHED; PG8_LDA(At, 1, 0); PG8_STAGE(PG8_SA(0, 1), a2 + hstep, voffA);
            PG8_WAIT_L(8); PG8_BAR; PG8_WAIT_L(0); PG8_MMA(0, 0, At, B0); PG8_BAR; PG8_SCHED;
            PG8_LDB(B1, 1, 1); PG8_STAGE(PG8_SB(1, 0), b3, voffB);
            PG8_BAR; PG8_WAIT_L(0); PG8_MMA(0, 1, At, B1); PG8_BAR;
            PG8_LDA(At, 1, 1); PG8_STAGE(PG8_SA(1, 0), a3, voffA);
            PG8_BAR; PG8_WAIT_L(0); PG8_MMA(1, 0, At, B0); PG8_BAR; PG8_SCHED;
            PG8_STAGE(PG8_SB(1, 1), b3 + hstep, voffB);
            PG8_WAIT_V(6); PG8_BAR; PG8_MMA(1, 1, At, B1); PG8_BAR;
            }
        }
        if constexpr (ALIGN_EPI) { if (wr == 0) PG8_BAR; }
        if constexpr (!Epi::AFTER_DRAIN) { E(acc, cur, wr, wc, fr, fq); S.done(cur); }
        if (!has_next) break;
#pragma unroll
        for (int a = 0; a < 2; ++a)
#pragma unroll
            for (int b = 0; b < 2; ++b)
#pragma unroll
                for (int m = 0; m < 4; ++m)
#pragma unroll
                    for (int n = 0; n < 2; ++n) acc[a][b][m][n] = (f32x4){0.f, 0.f, 0.f, 0.f};
        cur = nxt; cA = nA; cB = nB; ++ui;
        if constexpr (ALIGN_EPI) { if (wr == 1) PG8_BAR; }
    }
    PG8_WAIT_V(0);
    if constexpr (!ALIGN_EPI) { if (wr == 0) PG8_BAR; }
    PG8_BAR;
    if constexpr (Epi::AFTER_DRAIN) { E.fused(acc, cur, wr, wc, fr, fq, lds, wid, lane); S.done(cur); }
#undef PG8_SA
#undef PG8_SB
#undef PG8_STAGE
#undef PG8_LDA
#undef PG8_LDB
#undef PG8_MMA
#undef PG8_WAIT_V
#undef PG8_WAIT_L
#undef PG8_BAR
#undef PG8_SCHED
}
}
#define GAS __attribute__((address_space(1)))
#define LAS __attribute__((address_space(3)))
typedef unsigned short bf16;
typedef float f32x4 __attribute__((ext_vector_type(4)));
typedef unsigned u32x4 __attribute__((ext_vector_type(4)));
typedef GAS unsigned gu32;
#define LDS_WAIT() asm volatile("s_waitcnt lgkmcnt(0)" ::: "memory")
#define XB_TMO      128
#define XB_XCNT(j)  (256  + 64 * (j))
#define XB_XSUB(j)  (1280 + 64 * (j))
#define XB_XGEN(j)  (2304 + 64 * (j))
#define XB_TOP      3328
#define XB_TOPGEN   3392
#define XCD_BAR_WORDS 3456
#define XB_SPIN_CAP (1u << 18)

__device__ __forceinline__ unsigned xb_ld(unsigned* p)              { return __hip_atomic_load(p, __ATOMIC_RELAXED, __HIP_MEMORY_SCOPE_AGENT); }
__device__ __forceinline__ unsigned xb_add(unsigned* p, unsigned v) { return __hip_atomic_fetch_add(p, v, __ATOMIC_RELAXED, __HIP_MEMORY_SCOPE_AGENT); }
__device__ __forceinline__ unsigned xb_xcc_id() { return (unsigned)__builtin_amdgcn_s_getreg((3 << 11) | 20) & 0xFu; }
#define XB_SPIN(cond, bar) do { unsigned _sp = 0; while (cond) { __builtin_amdgcn_s_sleep(1); \
    if ((++_sp & 255u) == 0u) { if (xb_ld(&(bar)[XB_TMO])) break; if (_sp > XB_SPIN_CAP) { atomicAdd(&(bar)[XB_TMO], 1u); break; } } } } while (0)

struct XcdBarrier {
    unsigned* bar; unsigned x;
    volatile LAS unsigned* st;
};

__device__ __forceinline__ XcdBarrier xcd_barrier_post(unsigned* bar, volatile LAS unsigned* st) {
    XcdBarrier b; b.bar = bar; b.x = xb_xcc_id(); b.st = st;
    if (threadIdx.x == 0) (void)xb_add(&bar[XB_XCNT(b.x)], 1u);
    return b;
}
__device__ __forceinline__ void xcd_barrier_complete(unsigned* bar, unsigned x, unsigned& nloc, unsigned& nx) {
    const unsigned G = gridDim.x * gridDim.y * gridDim.z;
    unsigned sum, cnt, mine, sp = 0u;
    for (;;) {
        sum = 0u; cnt = 0u; mine = 0u;
#pragma unroll
        for (unsigned j = 0; j < 16; ++j) { const unsigned c = xb_ld(&bar[XB_XCNT(j)]); sum += c; cnt += (c > 0u) ? 1u : 0u; mine = (j == x) ? c : mine; }
        if (sum == G) break;
        __builtin_amdgcn_s_sleep(1);
        if ((++sp & 255u) == 0u) { if (xb_ld(&bar[XB_TMO])) break; if (sp > XB_SPIN_CAP) { atomicAdd(&bar[XB_TMO], 1u); break; } }
    }
    nloc = mine > 0u ? mine : 1u; nx = cnt > 0u ? cnt : 1u;
}

__device__ __forceinline__ void xcd_barrier(const XcdBarrier& b) {
    asm volatile("s_waitcnt vmcnt(0)" ::: "memory");
    __syncthreads();
    if (threadIdx.x == 0) {
        unsigned* bar = b.bar;
        __builtin_amdgcn_s_waitcnt(0);
        unsigned nloc = b.st[0], nx = b.st[1];
        if (nloc == 0u) { xcd_barrier_complete(bar, b.x, nloc, nx); b.st[0] = nloc; b.st[1] = nx; }
        const unsigned old = xb_add(&bar[XB_XSUB(b.x)], 1u);
        const unsigned gen = old / nloc;
        if (old + 1u == (gen + 1u) * nloc) {
            __builtin_amdgcn_fence(__ATOMIC_RELEASE, "agent");
            asm volatile("s_waitcnt vmcnt(0)" ::: "memory");
            const unsigned og = xb_add(&bar[XB_TOP], 1u);
            const unsigned tg = og / nx;
            if (og + 1u == (tg + 1u) * nx) xb_add(&bar[XB_TOPGEN], 1u);
            else XB_SPIN(xb_ld(&bar[XB_TOPGEN]) == tg, bar);
            __builtin_amdgcn_fence(__ATOMIC_ACQUIRE, "agent");
            xb_add(&bar[XB_XGEN(b.x)], 1u);
            asm volatile("s_waitcnt vmcnt(0)" ::: "memory");
        } else {
            XB_SPIN(xb_ld(&bar[XB_XGEN(b.x)]) == gen, bar);
            __builtin_amdgcn_fence(__ATOMIC_ACQUIRE, "agent");
            asm volatile("s_waitcnt vmcnt(0)" ::: "memory");
        }
    }
    __syncthreads();
}

#ifndef MK_N_LAUNCHES
#define DBG_NOSG 0
#define MK_N_LAUNCHES 1
#endif
constexpr int NWAVES = 8, NPHASE = 6;
constexpr int DM = 2048, NB = 4, SEQ = 2048, NS = 128, NH = 8;
constexpr int M1 = 8448, N1 = 7424;
constexpr int ROW_META = 8192, ROW_SAMP = 8208, ROWS1 = 8336;
constexpr int M2 = 8448, ROWS2 = 8320;
constexpr int NREC = 8 + NB * 32 * NH;
constexpr int REC_ELEMS = 49152, REC_N = 0, REC_Q = 16384, REC_B = 24576, REC_O = 40960;
constexpr float RMS_EPS = 1e-6f, LN_EPS = 1e-5f;
constexpr size_t O_Y = 0, O_YS = 16777216, O_SP = 17039360, O_GP = 17563648, O_CP = 17600512, O_SS = 17723392, O_GS = 34500608, O_CS = 35680256, O_END = 39612416;
constexpr size_t MiB = 1u << 20;
constexpr size_t WS_CTL = 0, CTL_ZERO_BYTES = 65536;
constexpr size_t WS_AB = 1 * MiB, WS_ROWSS = 1 * MiB + 768 * 1024, WS_DEC = 1 * MiB + 896 * 1024;
constexpr size_t WS_WT2 = 2 * MiB;
constexpr size_t WS_QKV = 10 * MiB;
constexpr size_t WS_ZG = WS_QKV + (size_t)M1 * 3072 * 2;
constexpr size_t WS_GLU = WS_ZG + (size_t)M1 * 1024 * 2;
constexpr size_t WS_ZC = WS_GLU + (size_t)M1 * 1024 * 2;
constexpr size_t WS_A2 = WS_ZC + (size_t)M1 * 1024 * 2;
constexpr size_t WS_REC = WS_A2 + (size_t)M2 * 2048 * 2;
constexpr size_t WS_XN = WS_REC;
constexpr size_t WS_WT1 = WS_XN + (size_t)M1 * 2048 * 2;
constexpr size_t WS_END = WS_REC + (size_t)NREC * REC_ELEMS * 2;
static_assert(WS_WT1 + (size_t)N1 * 2048 * 2 <= WS_END && WS_END <= 256 * MiB, "d_ws map");
static_assert(WS_AB + (size_t)M1 * 16 * 4 <= WS_ROWSS && WS_ROWSS + M2 * 4 <= WS_DEC && WS_DEC + NREC * 4 <= WS_WT2 && WS_WT2 + 2048u * 2048u * 2 <= WS_QKV, "d_ws map (small)");
constexpr int CW_TMO = 0, CW_CODE = 1, CW_BAR = 4096;
constexpr int LDS_BYTES = 147456, LDSCTL_OFF = 139264, MISC_OFF = LDSCTL_OFF + 320;

#define DI __device__ __forceinline__
typedef short bf16x8 __attribute__((ext_vector_type(8)));
typedef float f32x2 __attribute__((ext_vector_type(2)));
typedef unsigned u32x2 __attribute__((ext_vector_type(2)));
DI float bf_lo(unsigned u) { return __uint_as_float(u << 16); }
DI float bf_hi(unsigned u) { return __uint_as_float(u & 0xffff0000u); }
DI float bf2f(bf16 b) { return __uint_as_float((unsigned)b << 16); }
typedef __bf16 bf16x2_t __attribute__((ext_vector_type(2)));
DI unsigned pk(float lo, float hi) { f32x2 v = {lo, hi}; const bf16x2_t b = __builtin_convertvector(v, bf16x2_t); return __builtin_bit_cast(unsigned, b); }
DI bf16 f2b(float v) { return (bf16)(pk(v, 0.f) & 0xffffu); }
DI float sigm(float x) { return 1.f / (1.f + __expf(-x)); }
DI float silu(float x) { return x / (1.f + __expf(-x)); }
DI f32x4 mfma16(bf16x8 a, bf16x8 b, f32x4 c) { return __builtin_amdgcn_mfma_f32_16x16x32_bf16(a, b, c, 0, 0, 0); }
DI float wave_sum(float v) {
#pragma unroll
    for (int o = 1; o < 64; o <<= 1) v += __shfl_xor(v, o);
    return v;
}
DI float dot4(f32x4 a) { return (a.x * a.x + a.y * a.y) + (a.z * a.z + a.w * a.w); }

DI LAS unsigned char* opaque_lds(LAS unsigned char* p) { unsigned v = (unsigned)(uintptr_t)p; asm volatile("" : "+s"(v)); return (LAS unsigned char*)(uintptr_t)v; }
struct Ctx {
    const float *xp, *xs, *sS, *sgc, *scc, *meta, *normw, *win, *gcw, *alog, *dtb, *gnw, *cdw, *cdb, *clw, *clb, *wout, *fnw;
    float* out;
    gu32* ctl; float* AB; float* ROWSS; float* DEC;
    bf16 *WT1, *WT2, *XN, *QKV, *ZG, *GLU, *ZC, *A2, *REC;
    int tid, lane, wave, vcu, G, bx;
};

DI int orig_col(int n) {
    if (n < 3072) return n;
    if (n < 4096) return n + 16;
    if (n < 6144) { const int q = n - 4096, T = q >> 8, w = q & 255; return (w < 128) ? 4112 + T * 128 + w : 5136 + T * 128 + (w - 128); }
    if (n < 7168) return 6160 + (n - 6144);
    if (n < 7184) return 3072 + (n - 7168);
    return -1;
}
DI void p0_transpose_item(const float* W, int ldw, int K, bf16* WT, bool mapcols, LAS float* scr, int item, int nblk, int lane) {
    const int kb = item / nblk, nb = item % nblk, k0 = 64 * kb, n0 = 32 * nb;
    const int nn = n0 + (lane & 31); const int oc = mapcols ? orig_col(nn) : nn;
#pragma unroll 8
    for (int i = 0; i < 32; ++i) { const int kk = 2 * i + (lane >> 5); scr[kk * 33 + (lane & 31)] = oc >= 0 ? W[(size_t)(k0 + kk) * ldw + oc] : 0.f; }
    LDS_WAIT(); asm volatile("" ::: "memory");
    const int c = lane & 7;
#pragma unroll
    for (int j = 0; j < 4; ++j) { const int n = (lane >> 3) + 8 * j; const LAS float* s = scr + (8 * c) * 33 + n;
        u32x4 o; o.x = pk(s[0 * 33], s[1 * 33]); o.y = pk(s[2 * 33], s[3 * 33]); o.z = pk(s[4 * 33], s[5 * 33]); o.w = pk(s[6 * 33], s[7 * 33]);
        *(u32x4*)(WT + (size_t)(n0 + n) * K + k0 + 8 * c) = o; }
    LDS_WAIT(); asm volatile("" ::: "memory");
}
DI void p0_prologue(const Ctx& C, LAS unsigned char* lds) {
    LAS float* scr = (LAS float*)(lds + C.wave * 16384);
    const int gw = C.vcu * NWAVES + C.wave, NGW = C.G * NWAVES;
    constexpr int I1 = (DM / 64) * (N1 / 32), I2 = (DM / 64) * (DM / 32);
    for (int it = gw; it < I1 + I2; it += NGW) {
        if (it < I1) p0_transpose_item(C.win, 7184, DM, C.WT1, true, scr, it, N1 / 32, C.lane);
        else p0_transpose_item(C.wout, DM, DM, C.WT2, false, scr, it - I1, DM / 32, C.lane);
    }
    for (int m = gw; m < ROWS1; m += NGW) {
        const float* xr = m < ROW_META ? C.xp + (size_t)m * DM : (m < ROW_SAMP ? C.meta + (size_t)(m - ROW_META) * DM : C.xs + (size_t)(m - ROW_SAMP) * DM);
        f32x4 v[8]; float s = 0.f;
#pragma unroll
        for (int j = 0; j < 8; ++j) { v[j] = *(const f32x4*)(xr + 4 * C.lane + 256 * j); s += dot4(v[j]); }
        const float rs = rsqrtf(wave_sum(s) * (1.f / DM) + RMS_EPS);
        bf16* orow = C.XN + (size_t)m * DM;
#pragma unroll
        for (int j = 0; j < 8; ++j) { const f32x4 w = *(const f32x4*)(C.normw + 4 * C.lane + 256 * j);
            u32x2 o; o.x = pk(v[j].x * rs * w.x, v[j].y * rs * w.y); o.y = pk(v[j].z * rs * w.z, v[j].w * rs * w.w);
            *(u32x2*)(orow + 4 * C.lane + 256 * j) = o; }
    }
    for (int i = C.vcu * 512 + C.tid; i < M2; i += C.G * 512) C.ROWSS[i] = 0.f;
}

struct EpiP1 {
    static constexpr bool PERM = true, AFTER_DRAIN = false;
    bf16 *QKV, *ZG, *GLU, *ZC; float* AB;
    DI void operator()(const f32x4 (&acc)[2][2][4][2], const pg8::Unit& u, int wr, int wc, int fr, int fq) const {
        const int row0 = u.pm * 256 + wr * 64 + fr, pn = u.pn, cl = wc * 32 + 8 * fq;
        if (pn < 16 || (pn >= 24 && pn < 28)) {
            bf16* base; int ld, col0; bool act;
            if (pn < 12) { base = QKV; ld = 3072; col0 = pn * 256; act = false; }
            else if (pn < 16) { base = ZG; ld = 1024; col0 = (pn - 12) * 256; act = true; }
            else { base = ZC; ld = 1024; col0 = (pn - 24) * 256; act = true; }
#pragma unroll
            for (int ai = 0; ai < 2; ++ai)
#pragma unroll
                for (int m = 0; m < 4; ++m) { bf16* rowp = base + (size_t)(row0 + ai * 128 + m * 16) * ld + col0 + cl;
#pragma unroll
                    for (int bj = 0; bj < 2; ++bj) { f32x4 v0 = acc[ai][bj][m][0], v1 = acc[ai][bj][m][1];
                        if (act) { v0 = (f32x4){silu(v0.x), silu(v0.y), silu(v0.z), silu(v0.w)}; v1 = (f32x4){silu(v1.x), silu(v1.y), silu(v1.z), silu(v1.w)}; }
                        u32x4 w; w.x = pk(v0.x, v0.y); w.y = pk(v0.z, v0.w); w.z = pk(v1.x, v1.y); w.w = pk(v1.z, v1.w);
                        *(u32x4*)(rowp + bj * 128) = w; } }
        } else if (pn < 24) {
            const int T = pn - 16;
#pragma unroll
            for (int ai = 0; ai < 2; ++ai)
#pragma unroll
                for (int m = 0; m < 4; ++m) { bf16* rowp = GLU + (size_t)(row0 + ai * 128 + m * 16) * 1024 + T * 128 + cl;
                    const f32x4 a0 = acc[ai][0][m][0], a1 = acc[ai][0][m][1], b0 = acc[ai][1][m][0], b1 = acc[ai][1][m][1];
                    u32x4 w; w.x = pk(a0.x * sigm(b0.x), a0.y * sigm(b0.y)); w.y = pk(a0.z * sigm(b0.z), a0.w * sigm(b0.w));
                    w.z = pk(a1.x * sigm(b1.x), a1.y * sigm(b1.y)); w.w = pk(a1.z * sigm(b1.z), a1.w * sigm(b1.w));
                    *(u32x4*)rowp = w; }
        } else {
            if (wc == 0 && fq < 2) {
#pragma unroll
                for (int ai = 0; ai < 2; ++ai)
#pragma unroll
                    for (int m = 0; m < 4; ++m) { float* rowp = AB + (size_t)(row0 + ai * 128 + m * 16) * 16 + 8 * fq;
                        *(f32x4*)rowp = acc[ai][0][m][0]; *(f32x4*)(rowp + 4) = acc[ai][0][m][1]; }
            }
        }
    }
};
struct EpiRes {
    static constexpr bool PERM = false, AFTER_DRAIN = false;
    const float *xp, *xs; float* out; float* rowss; int row_base;
    DI void operator()(const f32x4 (&acc)[2][2][4][2], const pg8::Unit& u, int wr, int wc, int fr, int fq) const {
        const int col0 = u.pn * 256 + wc * 32 + 4 * fq;
#pragma unroll
        for (int ai = 0; ai < 2; ++ai)
#pragma unroll
            for (int m = 0; m < 4; ++m) {
                const int grow = row_base + u.pm * 256 + ai * 128 + wr * 64 + m * 16 + fr;
                if (grow < ROWS2) {
                    const float* xr = grow < 8192 ? xp + (size_t)grow * DM : xs + (size_t)(grow - 8192) * DM;
                    float* orow = grow < 8192 ? out + O_Y + (size_t)grow * DM : out + O_YS + (size_t)(grow - 8192) * DM;
                    float ss = 0.f;
#pragma unroll
                    for (int bj = 0; bj < 2; ++bj)
#pragma unroll
                        for (int n = 0; n < 2; ++n) { const int c = col0 + bj * 128 + n * 16; const f32x4 hv = *(const f32x4*)(xr + c) + acc[ai][bj][m][n]; *(f32x4*)(orow + c) = hv; ss += dot4(hv); }
                    ss += __shfl_xor(ss, 16); ss += __shfl_xor(ss, 32);
                    if (fq == 0) atomicAdd(rowss + grow, ss);
                }
            }
    }
};

DI int rowof(int b, int pos) { return pos < 48 ? -1 : (pos < 64 ? ROW_META + pos - 48 : b * SEQ + pos - 64); }
DI void p2_gdn_item(const Ctx& C, int item, LAS unsigned char* lds_in) {
    LAS unsigned char* lds = opaque_lds(lds_in);
    const int tid = C.tid, lane = C.lane, wave = C.wave, fr = lane & 15, fq = lane >> 4;
    int b, cp, h;
    if (item < 8) { b = 0; cp = 0; h = item; } else { int r = item - 8; h = r & 7; r >>= 3; cp = 1 + (r & 31); b = r >> 5; }
    LAS bf16* LQ = (LAS bf16*)(lds + 0);
    LAS bf16* LK = (LAS bf16*)(lds + 17408);
    LAS float* LA = (LAS float*)(lds + 35840);
    LAS bf16* LKT = (LAS bf16*)(lds + 54272);
    LAS bf16* LKD = (LAS bf16*)(lds + 72704);
    LAS bf16* LVT = (LAS bf16*)(lds + 91136);
    LAS bf16* LP = (LAS bf16*)(lds + 109568);
    LAS bf16* LTK = (LAS bf16*)(lds + 118784);
    LAS bf16* LTV = (LAS bf16*)(lds + 128000);
    LAS float* SMG = (LAS float*)(lds + 137216);
    LAS bf16* LWT = LK;
    LAS bf16* LUT = (LAS bf16*)(lds + 35840);
    bf16* R = C.REC + (size_t)item * REC_ELEMS;
    if (wave == 0) {
        const int row = rowof(b, 64 * cp + lane);
        float g = 0.f, be = 0.f;
        if (row >= 0) { const float al = C.AB[(size_t)row * 16 + h], br = C.AB[(size_t)row * 16 + 8 + h];
            const float x = al + C.dtb[h]; const float sp = x > 20.f ? x : log1pf(__expf(x));
            g = -__expf(C.alog[h]) * sp; be = sigm(br); }
        float gc = g;
#pragma unroll
        for (int o = 1; o < 64; o <<= 1) { const float v = __shfl_up(gc, o); if (lane >= o) gc += v; }
        const float gl = __shfl(gc, 63);
        SMG[lane] = gc; SMG[64 + lane] = be; SMG[128 + lane] = __expf(gl - gc); SMG[192 + lane] = __expf(gc);
        if (lane == 0) C.DEC[item] = __expf(gl);
    }
    __syncthreads();
    {
        const int cg = tid & 15, t0 = 2 * (tid >> 4);
        u32x4 raw[3][5];
#pragma unroll
        for (int j = 0; j < 5; ++j) {
            const int row = rowof(b, 64 * cp + t0 - 3 + j);
#pragma unroll
            for (int z = 0; z < 3; ++z) {
                u32x4 v = {0u, 0u, 0u, 0u};
                if (row >= 0) v = *(const u32x4*)(C.QKV + (size_t)row * 3072 + z * 1024 + h * 128 + cg * 8);
                raw[z][j] = v;
            }
        }
#pragma unroll
        for (int z = 0; z < 3; ++z) {
            asm volatile("" ::: "memory");
            const int col = z * 1024 + h * 128 + cg * 8;
            f32x4 w0[4], w1[4];
#pragma unroll
            for (int j = 0; j < 4; ++j) { w0[j] = *(const f32x4*)(C.gcw + j * 3072 + col); w1[j] = *(const f32x4*)(C.gcw + j * 3072 + col + 4); }
#pragma unroll
            for (int i = 0; i < 2; ++i) {
                const int t = t0 + i;
                float y[8];
#pragma unroll
                for (int e = 0; e < 8; ++e) y[e] = 0.f;
#pragma unroll
                for (int j = 0; j < 4; ++j) { const u32x4 r4 = raw[z][i + j];
                    y[0] += w0[j].x * bf_lo(r4.x); y[1] += w0[j].y * bf_hi(r4.x); y[2] += w0[j].z * bf_lo(r4.y); y[3] += w0[j].w * bf_hi(r4.y);
                    y[4] += w1[j].x * bf_lo(r4.z); y[5] += w1[j].y * bf_hi(r4.z); y[6] += w1[j].z * bf_lo(r4.w); y[7] += w1[j].w * bf_hi(r4.w); }
                float ss = 0.f;
#pragma unroll
                for (int e = 0; e < 8; ++e) { y[e] = silu(y[e]); ss += y[e] * y[e]; }
                if (z < 2) {
                    ss += __shfl_xor(ss, 1); ss += __shfl_xor(ss, 2); ss += __shfl_xor(ss, 4); ss += __shfl_xor(ss, 8);
                    const float sc = rsqrtf(ss + RMS_EPS) * (z == 0 ? 0.08838834764831845f : 1.f);
#pragma unroll
                    for (int e = 0; e < 8; ++e) y[e] *= sc;
                }
                u32x4 pw; pw.x = pk(y[0], y[1]); pw.y = pk(y[2], y[3]); pw.z = pk(y[4], y[5]); pw.w = pk(y[6], y[7]);
                if (z == 0) *(LAS u32x4*)(LQ + t * 136 + cg * 8) = pw;
                else if (z == 1) {
                    const float et = SMG[128 + t];
                    *(LAS u32x4*)(LK + t * 144 + cg * 8) = pw;
#pragma unroll
                    for (int e = 0; e < 8; ++e) { LKT[(cg * 8 + e) * 72 + t] = f2b(y[e]); LKD[(cg * 8 + e) * 72 + t] = f2b(y[e] * et); }
                } else {
#pragma unroll
                    for (int e = 0; e < 8; ++e) LVT[(cg * 8 + e) * 72 + t] = f2b(y[e]);
                }
            }
        }
    }
    __syncthreads();
    {
        const int kind = wave >> 2, ti = wave & 3;
#pragma unroll
        for (int tj = 0; tj < 4; ++tj) {
            if (tj <= ti) {
                f32x4 acc = {0.f, 0.f, 0.f, 0.f};
#pragma unroll
                for (int s = 0; s < 4; ++s) {
                    const bf16x8 a = kind == 0 ? *(const LAS bf16x8*)(LK + (16 * ti + fr) * 144 + 32 * s + 8 * fq) : *(const LAS bf16x8*)(LQ + (16 * ti + fr) * 136 + 32 * s + 8 * fq);
                    const bf16x8 bb = *(const LAS bf16x8*)(LK + (16 * tj + fr) * 144 + 32 * s + 8 * fq);
                    acc = mfma16(a, bb, acc);
                }
                const int j = 16 * tj + fr; const float gj = SMG[j];
#pragma unroll
                for (int r = 0; r < 4; ++r) { const int i = 16 * ti + 4 * fq + r; const float gm = __expf(fminf(SMG[i] - gj, 0.f));
                    if (kind == 0) LA[i * 72 + j] = (i > j) ? SMG[64 + i] * acc[r] * gm : 0.f;
                    else LP[i * 72 + j] = f2b((i >= j) ? acc[r] * gm : 0.f); }
            } else if (kind == 1) {
#pragma unroll
                for (int r = 0; r < 4; ++r) LP[(16 * ti + 4 * fq + r) * 72 + 16 * tj + fr] = (bf16)0;
            }
        }
    }
    __syncthreads();
    if (wave == 0) {
        float x[64];
        int ln = lane; asm volatile("" : "+v"(ln));
#pragma unroll
        for (int i = 0; i < 64; ++i) {
            float acc = (ln == i) ? 1.f : 0.f;
#pragma unroll
            for (int m4 = 0; m4 < i; m4 += 4) {
                const f32x4 a = *(const LAS f32x4*)(LA + i * 72 + m4);
                acc -= a.x * x[m4];
                if (m4 + 1 < i) acc -= a.y * x[m4 + 1];
                if (m4 + 2 < i) acc -= a.z * x[m4 + 2];
                if (m4 + 3 < i) acc -= a.w * x[m4 + 3];
            }
            x[i] = acc;
            if ((i & 3) == 3) asm volatile("" ::: "memory");
        }
        const float cb = SMG[64 + lane], ck = cb * SMG[192 + lane];
#pragma unroll
        for (int i = 0; i < 64; ++i) { LTK[i * 72 + lane] = f2b(x[i] * ck); LTV[i * 72 + lane] = f2b(x[i] * cb); }
    }
    __syncthreads();
    {
        const int tens = wave >> 2, ti = wave & 3;
        const LAS bf16* T = tens == 0 ? LTK : LTV; const LAS bf16* Y = tens == 0 ? LKT : LVT; LAS bf16* OUT = tens == 0 ? LWT : LUT;
        const bf16x8 a0 = *(const LAS bf16x8*)(T + (16 * ti + fr) * 72 + 8 * fq), a1 = *(const LAS bf16x8*)(T + (16 * ti + fr) * 72 + 32 + 8 * fq);
#pragma unroll
        for (int td = 0; td < 8; ++td) {
            f32x4 acc = {0.f, 0.f, 0.f, 0.f};
            const bf16x8 b0 = *(const LAS bf16x8*)(Y + (16 * td + fr) * 72 + 8 * fq), b1 = *(const LAS bf16x8*)(Y + (16 * td + fr) * 72 + 32 + 8 * fq);
            acc = mfma16(a0, b0, acc); acc = mfma16(a1, b1, acc);
            u32x2 o; o.x = pk(acc[0], acc[1]); o.y = pk(acc[2], acc[3]);
            *(LAS u32x2*)(OUT + (16 * td + fr) * 72 + 16 * ti + 4 * fq) = o;
        }
    }
    __syncthreads();
    {
        const int ta = wave;
        const bf16x8 kb0 = *(const LAS bf16x8*)(LKD + (16 * ta + fr) * 72 + 8 * fq), kb1 = *(const LAS bf16x8*)(LKD + (16 * ta + fr) * 72 + 32 + 8 * fq);
#pragma unroll
        for (int s = 0; s < 4; ++s) {
            f32x4 c0 = {0.f, 0.f, 0.f, 0.f}, c1 = {0.f, 0.f, 0.f, 0.f};
            const LAS bf16* w0p = LWT + (32 * s + fr) * 72 + 8 * fq; const LAS bf16* w1p = LWT + (32 * s + 16 + fr) * 72 + 8 * fq;
            c0 = mfma16(*(const LAS bf16x8*)w0p, kb0, c0); c0 = mfma16(*(const LAS bf16x8*)(w0p + 32), kb1, c0);
            c1 = mfma16(*(const LAS bf16x8*)w1p, kb0, c1); c1 = mfma16(*(const LAS bf16x8*)(w1p + 32), kb1, c1);
            u32x4 o; o.x = pk(-c0[0], -c0[1]); o.y = pk(-c0[2], -c0[3]); o.z = pk(-c1[0], -c1[1]); o.w = pk(-c1[2], -c1[3]);
            *(u32x4*)(R + REC_N + ((ta * 4 + s) * 64 + lane) * 8) = o;
        }
#pragma unroll
        for (int tv = 0; tv < 8; ++tv) {
            f32x4 c = {0.f, 0.f, 0.f, 0.f};
            const LAS bf16* up = LUT + (16 * tv + fr) * 72 + 8 * fq;
            c = mfma16(kb0, *(const LAS bf16x8*)up, c); c = mfma16(kb1, *(const LAS bf16x8*)(up + 32), c);
            u32x2 o; o.x = pk(c[0], c[1]); o.y = pk(c[2], c[3]);
            *(u32x2*)(R + REC_B + ((tv * 8 + ta) * 64 + lane) * 4) = o;
        }
    }
    {
        const int ti = wave & 3, hf = wave >> 2;
        const bf16x8 p0 = *(const LAS bf16x8*)(LP + (16 * ti + fr) * 72 + 8 * fq), p1 = *(const LAS bf16x8*)(LP + (16 * ti + fr) * 72 + 32 + 8 * fq);
        const int i = 16 * ti + fr; const float eg = SMG[192 + i];
#pragma unroll
        for (int s2 = 0; s2 < 2; ++s2) {
            const int s = 2 * hf + s2;
            f32x4 c0 = {0.f, 0.f, 0.f, 0.f}, c1 = {0.f, 0.f, 0.f, 0.f};
            const LAS bf16* w0p = LWT + (32 * s + fr) * 72 + 8 * fq; const LAS bf16* w1p = LWT + (32 * s + 16 + fr) * 72 + 8 * fq;
            c0 = mfma16(*(const LAS bf16x8*)w0p, p0, c0); c0 = mfma16(*(const LAS bf16x8*)(w0p + 32), p1, c0);
            c1 = mfma16(*(const LAS bf16x8*)w1p, p0, c1); c1 = mfma16(*(const LAS bf16x8*)(w1p + 32), p1, c1);
            const u32x2 q0 = *(const LAS u32x2*)(LQ + i * 136 + 32 * s + 4 * fq), q1 = *(const LAS u32x2*)(LQ + i * 136 + 32 * s + 16 + 4 * fq);
            u32x4 o; o.x = pk(eg * bf_lo(q0.x) - c0[0], eg * bf_hi(q0.x) - c0[1]); o.y = pk(eg * bf_lo(q0.y) - c0[2], eg * bf_hi(q0.y) - c0[3]);
            o.z = pk(eg * bf_lo(q1.x) - c1[0], eg * bf_hi(q1.x) - c1[1]); o.w = pk(eg * bf_lo(q1.y) - c1[2], eg * bf_hi(q1.y) - c1[3]);
            *(u32x4*)(R + REC_Q + ((ti * 4 + s) * 64 + lane) * 8) = o;
        }
#pragma unroll
        for (int t2 = 0; t2 < 4; ++t2) {
            const int tv = 4 * hf + t2;
            f32x4 c = {0.f, 0.f, 0.f, 0.f};
            const LAS bf16* up = LUT + (16 * tv + fr) * 72 + 8 * fq;
            c = mfma16(p0, *(const LAS bf16x8*)up, c); c = mfma16(p1, *(const LAS bf16x8*)(up + 32), c);
            u32x2 o; o.x = pk(c[0], c[1]); o.y = pk(c[2], c[3]);
            *(u32x2*)(R + REC_O + ((tv * 4 + ti) * 64 + lane) * 4) = o;
        }
    }
    __syncthreads();
}

DI void conv_rows16(f32x2 (&acc)[16], const f32x2 (&w)[31], const LAS unsigned* LT0, int tid) {
#pragma unroll
    for (int p = 0; p < 46; ++p) {
        const unsigned u = LT0[p * 512 + tid]; const float x0 = bf_lo(u), x1 = bf_hi(u);
#pragma unroll
        for (int t = 0; t < 16; ++t) { if (p - t >= 0 && p - t <= 30) { acc[t].x += w[p - t].x * x0; acc[t].y += w[p - t].y * x1; } }
    }
}
DI void p2_conf_item(const Ctx& C, int item, LAS unsigned char* lds_in) {
    LAS unsigned char* lds = opaque_lds(lds_in);
    const int tid = C.tid, lane = C.lane, wave = C.wave;
    const int b = item >> 6, t0 = (item & 63) * 32;
    LAS unsigned* LT = (LAS unsigned*)lds;
    LAS float* LPART = (LAS float*)(lds + 126976);
    LAS float* LSTAT = (LAS float*)(lds + 126976 + 2048);
    for (int q = tid; q < 62 * 128; q += 512) {
        const int rr = q >> 7, c16 = q & 127, p = t0 - 30 + rr;
        const int row = p >= 0 ? b * SEQ + p : (p >= -16 ? ROW_META + 16 + p : -1);
        u32x4 v = {0u, 0u, 0u, 0u};
        if (row >= 0) v = *(const u32x4*)(C.GLU + (size_t)row * 1024 + c16 * 8);
        *(LAS u32x4*)(lds + rr * 2048 + c16 * 16) = v;
    }
    __syncthreads();
    const int ch = 2 * tid;
    f32x2 w[31];
#pragma unroll
    for (int j = 0; j < 31; ++j) { unsigned o = ch + j * 1024; asm volatile("" : "+v"(o)); w[j] = *(const f32x2*)(C.cdw + o); }
    const f32x2 bias = *(const f32x2*)(C.cdb + ch);
    f32x2 acc[32];
    {
        f32x2 accA[16], accB[16];
#pragma unroll
        for (int t = 0; t < 16; ++t) { accA[t] = bias; accB[t] = bias; }
        conv_rows16(accA, w, LT, tid);
        conv_rows16(accB, w, LT + 16 * 512, tid);
#pragma unroll
        for (int t = 0; t < 16; ++t) { acc[t] = accA[t]; acc[16 + t] = accB[t]; }
    }
    float vals[64];
#pragma unroll
    for (int t = 0; t < 32; ++t) { vals[t] = acc[t].x + acc[t].y; vals[32 + t] = acc[t].x * acc[t].x + acc[t].y * acc[t].y; }
#define BFLY(off_, n_) { const bool up = (lane & off_) != 0; _Pragma("unroll") for (int i = 0; i < n_; ++i) { const float keep = up ? vals[i + n_] : vals[i]; const float send = up ? vals[i] : vals[i + n_]; vals[i] = keep + __shfl_xor(send, off_); } }
    BFLY(32, 32) BFLY(16, 16) BFLY(8, 8) BFLY(4, 4) BFLY(2, 2) BFLY(1, 1)
#undef BFLY
    LPART[wave * 64 + lane] = vals[0];
    __syncthreads();
    if (tid < 32) {
        float s1 = 0.f, s2 = 0.f;
#pragma unroll
        for (int wv = 0; wv < 8; ++wv) { s1 += LPART[wv * 64 + tid]; s2 += LPART[wv * 64 + 32 + tid]; }
        const float mean = s1 * (1.f / 1024.f); const float var = fmaxf(s2 * (1.f / 1024.f) - mean * mean, 0.f);
        LSTAT[2 * tid] = mean; LSTAT[2 * tid + 1] = rsqrtf(var + LN_EPS);
    }
    __syncthreads();
    const f32x2 lw = *(const f32x2*)(C.clw + ch), lb = *(const f32x2*)(C.clb + ch);
    unsigned zz[32];
#pragma unroll
    for (int t = 0; t < 32; ++t) { unsigned oz = (unsigned)(b * SEQ + t0 + t) * 1024 + ch; asm volatile("" : "+v"(oz)); zz[t] = *(const unsigned*)(C.ZC + oz); }
#pragma unroll
    for (int t = 0; t < 32; ++t) {
        const float mean = LSTAT[2 * t], rstd = LSTAT[2 * t + 1]; const size_t row = (size_t)b * SEQ + t0 + t;
        unsigned oa = (unsigned)row * 2048 + 1024 + ch; asm volatile("" : "+v"(oa));
        const unsigned z = zz[t];
        const float y0 = (acc[t].x - mean) * rstd * lw.x + lb.x, y1 = (acc[t].y - mean) * rstd * lw.y + lb.y;
        *(unsigned*)(C.A2 + oa) = pk(silu(y0) * bf_lo(z), silu(y1) * bf_hi(z));
    }
    if (t0 == SEQ - 32) {
#pragma unroll 2
        for (int rr = 32; rr < 62; ++rr) { const unsigned u = LT[rr * 512 + tid]; f32x2 o; o.x = bf_lo(u); o.y = bf_hi(u);
            *(f32x2*)(C.out + O_CP + ((size_t)b * 30 + rr - 32) * 1024 + ch) = o; }
    }
    __syncthreads();
}

DI void p2_sgdn_item(const Ctx& C, int item, LAS unsigned char* lds) {
    const int tid = C.tid, lane = C.lane, wave = C.wave;
    const int s = item >> 3, h = item & 7, row = ROW_SAMP + s;
    LAS float* Lq = (LAS float*)lds; LAS float* Lk = Lq + 128; LAS float* Lv = Lq + 256; LAS float* Lsc = Lq + 384; LAS float* Lvn = Lq + 400; LAS float* Lo = Lq + 528;
    LAS float* LrK = (LAS float*)(lds + 4096); LAS float* LrQ = (LAS float*)(lds + 4096 + 8192);
    const int v4 = (tid & 31) * 4, a0 = tid >> 5;
    const float* Sg = C.sS + (size_t)(s * 8 + h) * 16384;
    f32x4 Sv[8];
#pragma unroll
    for (int i = 0; i < 8; ++i) Sv[i] = *(const f32x4*)(Sg + (a0 + 16 * i) * 128 + v4);
    if (tid < 384) {
        const int z = tid >> 7, d = tid & 127, col = z * 1024 + h * 128 + d;
        const float* hs = C.sgc + (size_t)s * 3 * 3072 + col;
        const float h0 = hs[0], h1 = hs[3072], h2 = hs[6144], cur = bf2f(C.QKV[(size_t)row * 3072 + col]);
        const float x = C.gcw[col] * h0 + C.gcw[3072 + col] * h1 + C.gcw[6144 + col] * h2 + C.gcw[9216 + col] * cur;
        Lq[z * 128 + d] = silu(x);
        float* og = C.out + O_GS + (size_t)s * 3 * 3072 + col; og[0] = h1; og[3072] = h2; og[6144] = cur;
    }
    __syncthreads();
    if (wave == 0) {
        float q0 = Lq[lane], q1 = Lq[64 + lane], k0 = Lk[lane], k1 = Lk[64 + lane];
        const float scq = rsqrtf(wave_sum(q0 * q0 + q1 * q1) + RMS_EPS) * 0.08838834764831845f, sck = rsqrtf(wave_sum(k0 * k0 + k1 * k1) + RMS_EPS);
        q0 *= scq; q1 *= scq; k0 *= sck; k1 *= sck;
        Lq[lane] = q0; Lq[64 + lane] = q1; Lk[lane] = k0; Lk[64 + lane] = k1;
        const float qk = wave_sum(q0 * k0 + q1 * k1);
        if (lane == 0) { const float al = C.AB[(size_t)row * 16 + h], br = C.AB[(size_t)row * 16 + 8 + h];
            const float x = al + C.dtb[h]; const float sp = x > 20.f ? x : log1pf(__expf(x));
            Lsc[0] = __expf(-__expf(C.alog[h]) * sp); Lsc[1] = sigm(br); Lsc[2] = qk; }
    }
    __syncthreads();
    const float eg = Lsc[0], be = Lsc[1], qk = Lsc[2];
    f32x4 ks = {0.f, 0.f, 0.f, 0.f}, qs = {0.f, 0.f, 0.f, 0.f};
#pragma unroll
    for (int i = 0; i < 8; ++i) { const int a = a0 + 16 * i; ks += Lk[a] * Sv[i]; qs += Lq[a] * Sv[i]; }
    *(LAS f32x4*)(LrK + a0 * 128 + v4) = ks; *(LAS f32x4*)(LrQ + a0 * 128 + v4) = qs;
    __syncthreads();
    if (tid < 128) {
        float kS = 0.f, qS = 0.f;
#pragma unroll
        for (int r = 0; r < 16; ++r) { kS += LrK[r * 128 + tid]; qS += LrQ[r * 128 + tid]; }
        const float vn = be * (Lv[tid] - eg * kS);
        Lvn[tid] = vn; Lo[tid] = eg * qS + qk * vn;
    }
    __syncthreads();
    const f32x4 vn4 = *(const LAS f32x4*)(Lvn + v4);
    float* So = C.out + O_SS + (size_t)(s * 8 + h) * 16384;
#pragma unroll
    for (int i = 0; i < 8; ++i) { const int a = a0 + 16 * i; *(f32x4*)(So + a * 128 + v4) = eg * Sv[i] + Lk[a] * vn4; }
    if (wave == 0) {
        const float o0 = Lo[lane], o1 = Lo[64 + lane];
        const float rstd = rsqrtf(wave_sum(o0 * o0 + o1 * o1) * (1.f / 128.f) + RMS_EPS);
        const bf16* zg = C.ZG + (size_t)row * 1024 + h * 128; bf16* ao = C.A2 + (size_t)(8192 + s) * 2048 + h * 128;
        ao[lane] = f2b(o0 * rstd * C.gnw[lane] * bf2f(zg[lane])); ao[64 + lane] = f2b(o1 * rstd * C.gnw[64 + lane] * bf2f(zg[64 + lane]));
    }
    __syncthreads();
}
DI void p2_sconf_item(const Ctx& C, int s, LAS unsigned char* lds) {
    const int tid = C.tid, lane = C.lane, wave = C.wave;
    const int ch = 2 * tid, row = ROW_SAMP + s;
    LAS float* Lp = (LAS float*)lds;
    const float* hs = C.scc + (size_t)s * 30 * 1024 + ch; float* oc = C.out + O_CS + (size_t)s * 30 * 1024 + ch;
    f32x2 acc = *(const f32x2*)(C.cdb + ch);
    f32x2 hv[30];
#pragma unroll
    for (int j = 0; j < 30; ++j) { unsigned o = j * 1024; asm volatile("" : "+v"(o)); hv[j] = *(const f32x2*)(hs + o); }
#pragma unroll
    for (int j = 0; j < 30; ++j) { unsigned o = j * 1024 + ch; asm volatile("" : "+v"(o)); const f32x2 wj = *(const f32x2*)(C.cdw + o); acc += wj * hv[j];
        if (j >= 1) { unsigned oo = (j - 1) * 1024; asm volatile("" : "+v"(oo)); *(f32x2*)(oc + oo) = hv[j]; } }
    const unsigned gu = *(const unsigned*)(C.GLU + (size_t)row * 1024 + ch); f32x2 gv; gv.x = bf_lo(gu); gv.y = bf_hi(gu);
    acc += *(const f32x2*)(C.cdw + 30 * 1024 + ch) * gv; *(f32x2*)(oc + 29 * 1024) = gv;
    const float s1 = wave_sum(acc.x + acc.y), s2 = wave_sum(acc.x * acc.x + acc.y * acc.y);
    if (lane == 0) { Lp[wave * 2] = s1; Lp[wave * 2 + 1] = s2; }
    __syncthreads();
    float t1 = 0.f, t2 = 0.f;
#pragma unroll
    for (int wv = 0; wv < 8; ++wv) { t1 += Lp[wv * 2]; t2 += Lp[wv * 2 + 1]; }
    const float mean = t1 * (1.f / 1024.f), rstd = rsqrtf(fmaxf(t2 * (1.f / 1024.f) - mean * mean, 0.f) + LN_EPS);
    const f32x2 lw = *(const f32x2*)(C.clw + ch), lb = *(const f32x2*)(C.clb + ch);
    const unsigned z = *(const unsigned*)(C.ZC + (size_t)row * 1024 + ch);
    const float y0 = (acc.x - mean) * rstd * lw.x + lb.x, y1 = (acc.y - mean) * rstd * lw.y + lb.y;
    *(unsigned*)(C.A2 + (size_t)(8192 + s) * 2048 + 1024 + ch) = pk(silu(y0) * bf_lo(z), silu(y1) * bf_hi(z));
    __syncthreads();
}
DI void p2_misc_item(const Ctx& C) {
    for (int i = C.tid; i < NB * 3 * 3072; i += 512) { const int col = i % 3072, j = (i / 3072) % 3, b = i / 9216;
        C.out[O_GP + i] = bf2f(C.QKV[(size_t)(b * SEQ + SEQ - 3 + j) * 3072 + col]); }
}
DI void p2_phase(const Ctx& C, LAS unsigned char* lds, int mask) {
#ifdef DBG_P2C
    mask = DBG_P2C;
#endif
    if (mask & 1) for (int it = C.vcu; it < NREC; it += C.G) p2_gdn_item(C, it, lds);
    if (mask & 4) for (int it = C.vcu; it < NS * NH; it += C.G) p2_sgdn_item(C, it, lds);
    if (mask & 8) for (int it = C.G - 1 - C.vcu; it < NS; it += C.G) p2_sconf_item(C, it, lds);
    if (mask & 16) if (C.vcu == C.G / 2) p2_misc_item(C);
}

DI const bf16* rec_ptr(const Ctx& C, int b, int h, int c) { const int rec = c == 0 ? h : 8 + ((b * 32 + c - 1) * 8 + h); return C.REC + (size_t)rec * REC_ELEMS; }
DI void p3_scan(const Ctx& C, int bh, LAS unsigned char* lds) {
    const int tid = C.tid, lane = C.lane, wave = C.wave, fr = lane & 15, fq = lane >> 4;
    const int b = bh >> 3, h = bh & 7, tv = wave;
    LAS float* Lo = (LAS float*)(lds + 98304);
    f32x4 S[8]; bf16x8 Sb[4];
#pragma unroll
    for (int i = 0; i < 8; ++i) S[i] = (f32x4){0.f, 0.f, 0.f, 0.f};
#pragma unroll
    for (int i = 0; i < 4; ++i) Sb[i] = (bf16x8){0, 0, 0, 0, 0, 0, 0, 0};
    const int frow = tid >> 3, fcb = (tid & 7) * 16;
    const f32x4 gw0 = *(const f32x4*)(C.gnw + fcb), gw1 = *(const f32x4*)(C.gnw + fcb + 4), gw2 = *(const f32x4*)(C.gnw + fcb + 8), gw3 = *(const f32x4*)(C.gnw + fcb + 12);
    u32x4 nF[6]; u32x2 nB[8], nO[4];
    {
        const bf16* r0 = rec_ptr(C, b, h, 0);
#pragma unroll
        for (int i = 0; i < 6; ++i) nF[i] = *(const u32x4*)(r0 + (i * 512 + tid) * 8);
#pragma unroll
        for (int ta = 0; ta < 8; ++ta) nB[ta] = *(const u32x2*)(r0 + REC_B + ((tv * 8 + ta) * 64 + lane) * 4);
#pragma unroll
        for (int ti = 0; ti < 4; ++ti) nO[ti] = *(const u32x2*)(r0 + REC_O + ((tv * 4 + ti) * 64 + lane) * 4);
#pragma unroll
        for (int i = 0; i < 6; ++i) *(LAS u32x4*)(lds + (i * 512 + tid) * 16) = nF[i];
    }
    for (int c = 0; c < 33; ++c) {
        __syncthreads();
        u32x2 cB[8], cO[4];
#pragma unroll
        for (int ta = 0; ta < 8; ++ta) cB[ta] = nB[ta];
#pragma unroll
        for (int ti = 0; ti < 4; ++ti) cO[ti] = nO[ti];
        const float dec = C.DEC[c == 0 ? h : 8 + ((b * 32 + c - 1) * 8 + h)];
        const size_t grow = (size_t)b * SEQ + (c >= 1 ? (c - 1) * 64 : 0) + frow;
        const u32x4 z0 = *(const u32x4*)(C.ZG + grow * 1024 + h * 128 + fcb), z1 = *(const u32x4*)(C.ZG + grow * 1024 + h * 128 + fcb + 8);
        if (c + 1 < 33) {
            const bf16* r1 = rec_ptr(C, b, h, c + 1);
#pragma unroll
            for (int ta = 0; ta < 8; ++ta) nB[ta] = *(const u32x2*)(r1 + REC_B + ((tv * 8 + ta) * 64 + lane) * 4);
#pragma unroll
            for (int ti = 0; ti < 4; ++ti) nO[ti] = *(const u32x2*)(r1 + REC_O + ((tv * 4 + ti) * 64 + lane) * 4);
#pragma unroll
            for (int i = 0; i < 6; ++i) nF[i] = *(const u32x4*)(r1 + (i * 512 + tid) * 8);
        }
        const LAS bf16* F = (const LAS bf16*)(lds + (c & 1) * 49152);
        if (c >= 1) {
#pragma unroll
            for (int ti = 0; ti < 4; ++ti) {
                f32x4 acc = {bf_lo(cO[ti].x), bf_hi(cO[ti].x), bf_lo(cO[ti].y), bf_hi(cO[ti].y)};
#pragma unroll
                for (int s = 0; s < 4; ++s) acc = mfma16(*(const LAS bf16x8*)(F + REC_Q + ((ti * 4 + s) * 64 + lane) * 8), Sb[s], acc);
#pragma unroll
                for (int r = 0; r < 4; ++r) Lo[(16 * ti + 4 * fq + r) * 132 + 16 * tv + fr] = acc[r];
            }
        }
#pragma unroll
        for (int ta = 0; ta < 8; ++ta) {
            f32x4 acc = dec * S[ta] + (f32x4){bf_lo(cB[ta].x), bf_hi(cB[ta].x), bf_lo(cB[ta].y), bf_hi(cB[ta].y)};
#pragma unroll
            for (int s = 0; s < 4; ++s) acc = mfma16(*(const LAS bf16x8*)(F + REC_N + ((ta * 4 + s) * 64 + lane) * 8), Sb[s], acc);
            S[ta] = acc;
        }
#pragma unroll
        for (int s = 0; s < 4; ++s) {
            u32x4 p; p.x = pk(S[2 * s][0], S[2 * s][1]); p.y = pk(S[2 * s][2], S[2 * s][3]); p.z = pk(S[2 * s + 1][0], S[2 * s + 1][1]); p.w = pk(S[2 * s + 1][2], S[2 * s + 1][3]);
            Sb[s] = __builtin_bit_cast(bf16x8, p);
        }
        __syncthreads();
        if (c >= 1) {
            const LAS float* lo = Lo + frow * 132 + fcb;
            const f32x4 x0 = *(const LAS f32x4*)lo, x1 = *(const LAS f32x4*)(lo + 4), x2 = *(const LAS f32x4*)(lo + 8), x3 = *(const LAS f32x4*)(lo + 12);
            float ss = dot4(x0) + dot4(x1) + dot4(x2) + dot4(x3);
            ss += __shfl_xor(ss, 1); ss += __shfl_xor(ss, 2); ss += __shfl_xor(ss, 4);
            const float rstd = rsqrtf(ss * (1.f / 128.f) + RMS_EPS);
            u32x4 o0, o1;
            o0.x = pk(x0.x * rstd * gw0.x * bf_lo(z0.x), x0.y * rstd * gw0.y * bf_hi(z0.x)); o0.y = pk(x0.z * rstd * gw0.z * bf_lo(z0.y), x0.w * rstd * gw0.w * bf_hi(z0.y));
            o0.z = pk(x1.x * rstd * gw1.x * bf_lo(z0.z), x1.y * rstd * gw1.y * bf_hi(z0.z)); o0.w = pk(x1.z * rstd * gw1.z * bf_lo(z0.w), x1.w * rstd * gw1.w * bf_hi(z0.w));
            o1.x = pk(x2.x * rstd * gw2.x * bf_lo(z1.x), x2.y * rstd * gw2.y * bf_hi(z1.x)); o1.y = pk(x2.z * rstd * gw2.z * bf_lo(z1.y), x2.w * rstd * gw2.w * bf_hi(z1.y));
            o1.z = pk(x3.x * rstd * gw3.x * bf_lo(z1.z), x3.y * rstd * gw3.y * bf_hi(z1.z)); o1.w = pk(x3.z * rstd * gw3.z * bf_lo(z1.w), x3.w * rstd * gw3.w * bf_hi(z1.w));
            *(u32x4*)(C.A2 + grow * 2048 + h * 128 + fcb) = o0; *(u32x4*)(C.A2 + grow * 2048 + h * 128 + fcb + 8) = o1;
        }
        if (c + 1 < 33) {
#pragma unroll
            for (int i = 0; i < 6; ++i) *(LAS u32x4*)(lds + ((c + 1) & 1) * 49152 + (i * 512 + tid) * 16) = nF[i];
        }
    }
    float* so = C.out + O_SP + (size_t)(b * 8 + h) * 16384;
#pragma unroll
    for (int ta = 0; ta < 8; ++ta)
#pragma unroll
        for (int r = 0; r < 4; ++r) so[(16 * ta + 4 * fq + r) * 128 + 16 * tv + fr] = S[ta][r];
    __syncthreads();
}

DI void p5_final(const Ctx& C) {
    const int gw = C.vcu * NWAVES + C.wave, NGW = C.G * NWAVES;
    for (int m = gw; m < ROWS2; m += NGW) {
        float* orow = m < 8192 ? C.out + O_Y + (size_t)m * DM : C.out + O_YS + (size_t)(m - 8192) * DM;
        const float rs = rsqrtf(C.ROWSS[m] * (1.f / DM) + RMS_EPS);
#pragma unroll
        for (int j = 0; j < 8; ++j) { const f32x4 v = *(const f32x4*)(orow + 4 * C.lane + 256 * j); const f32x4 w = *(const f32x4*)(C.fnw + 4 * C.lane + 256 * j);
            *(f32x4*)(orow + 4 * C.lane + 256 * j) = v * rs * w; }
    }
}

struct Args { const float* in[18]; float* out; unsigned char* ws; int ph_lo, ph_hi, flags, pad; };
__global__ void __launch_bounds__(NWAVES * 64, 2) mk_fwd(Args args) {
    extern __shared__ __attribute__((aligned(16))) unsigned char lds_raw[];
    LAS unsigned char* lds = (LAS unsigned char*)lds_raw;
    Ctx C;
    C.tid = threadIdx.x; C.lane = C.tid & 63; C.wave = __builtin_amdgcn_readfirstlane(C.tid >> 6);
    C.G = gridDim.x; C.bx = blockIdx.x; C.vcu = (C.G % 8 == 0) ? (C.bx % 8) * (C.G / 8) + C.bx / 8 : C.bx;
    C.xp = args.in[0]; C.xs = args.in[1]; C.sS = args.in[2]; C.sgc = args.in[3]; C.scc = args.in[4]; C.meta = args.in[5]; C.normw = args.in[6]; C.win = args.in[7];
    C.gcw = args.in[8]; C.alog = args.in[9]; C.dtb = args.in[10]; C.gnw = args.in[11]; C.cdw = args.in[12]; C.cdb = args.in[13]; C.clw = args.in[14]; C.clb = args.in[15];
    C.wout = args.in[16]; C.fnw = args.in[17]; C.out = args.out;
    unsigned char* ws = args.ws;
    C.ctl = (gu32*)(ws + WS_CTL); C.AB = (float*)(ws + WS_AB); C.ROWSS = (float*)(ws + WS_ROWSS); C.DEC = (float*)(ws + WS_DEC);
    C.WT1 = (bf16*)(ws + WS_WT1); C.WT2 = (bf16*)(ws + WS_WT2); C.XN = (bf16*)(ws + WS_XN); C.QKV = (bf16*)(ws + WS_QKV); C.ZG = (bf16*)(ws + WS_ZG);
    C.GLU = (bf16*)(ws + WS_GLU); C.ZC = (bf16*)(ws + WS_ZC); C.A2 = (bf16*)(ws + WS_A2); C.REC = (bf16*)(ws + WS_REC);
    for (int u = C.tid; u < (LDS_BYTES - LDSCTL_OFF) / 4; u += NWAVES * 64) ((LAS unsigned*)(lds + LDSCTL_OFF))[u] = 0u;
    __syncthreads();
#ifdef DBG_LO
    const int lo = DBG_LO, hi = DBG_HI;
#else
    const int lo = args.ph_lo, hi = args.ph_hi;
#endif
    XcdBarrier bar; bar.bar = (unsigned*)(C.ctl + CW_BAR); bar.x = 0; bar.st = nullptr;
    if (hi - lo > 1) bar = xcd_barrier_post((unsigned*)(C.ctl + CW_BAR), (volatile LAS unsigned*)(lds + MISC_OFF) + 8);
#define IN(k) (lo <= (k) && (k) < hi)
#define SEAM(k) do { if (IN(k) && IN((k) + 1)) xcd_barrier(bar); } while (0)
    if (IN(0)) { p0_prologue(C, lds); }
    SEAM(0);
    if (IN(1)) {
        pg8::Gemm g{C.XN, C.WT1, M1, N1, DM}; pg8::StaticOrder S; S.init(M1, N1, C.G, C.bx);
        EpiP1 E{C.QKV, C.ZG, C.GLU, C.ZC, C.AB};
        pg8::gemm_phase<EpiP1, pg8::StaticOrder, true, true>(lds, g, S, E);
    }
    SEAM(1);
    if (IN(2)) { p2_phase(C, lds, (args.flags >> 8) ? (args.flags >> 8) : 31); }
    SEAM(2);
    if (IN(3)) {
        if (C.bx < 32) p3_scan(C, C.bx, lds);
        else if (C.bx < 40 && !(args.flags & 1)) {
            pg8::Gemm g{C.A2 + (size_t)8192 * 2048, C.WT2, 256, DM, DM}; pg8::StaticOrder S; S.init(256, DM, 8, C.bx - 32);
            EpiRes E{C.xp, C.xs, C.out, C.ROWSS, 8192};
            pg8::gemm_phase<EpiRes, pg8::StaticOrder, false, true>(lds, g, S, E);
        } else if (!(args.flags & 1)) {
            for (int it = C.bx - 40; it < NB * 64; it += C.G - 40) p2_conf_item(C, it, lds);
        }
    }
    SEAM(3);
    if (IN(4)) {
        pg8::Gemm g{C.A2, C.WT2, 8192, DM, DM}; pg8::StaticOrder S; S.init(8192, DM, C.G, C.bx);
        EpiRes E{C.xp, C.xs, C.out, C.ROWSS, 0};
        pg8::gemm_phase<EpiRes, pg8::StaticOrder, false, true>(lds, g, S, E);
    }
    SEAM(4);
    if (IN(5)) { p5_final(C); }
#undef IN
#undef SEAM
}

extern "C" void kernel_launch(void* const* d_in, const int* in_sizes, int n_in, void* d_out, int out_size, void* d_ws, size_t ws_size, hipStream_t stream) {
    static int grid = 0;
    if (grid == 0) {
        if (n_in != 18 || out_size != (int)O_END || ws_size < WS_END) { fprintf(stderr, "kernel_launch: unexpected shapes (n_in %d, out %d, ws %zu); nothing launched\n", n_in, out_size, ws_size); grid = -1; return; }
        int dev = 0, cus = 0, per_cu = 0;
        if (hipGetDevice(&dev) != hipSuccess || hipDeviceGetAttribute(&cus, hipDeviceAttributeMultiprocessorCount, dev) != hipSuccess) { fprintf(stderr, "kernel_launch: device query failed\n"); grid = -1; return; }
        if (hipFuncSetAttribute((const void*)mk_fwd, hipFuncAttributeMaxDynamicSharedMemorySize, LDS_BYTES) != hipSuccess) { fprintf(stderr, "kernel_launch: hipFuncSetAttribute failed\n"); grid = -1; return; }
        if (hipOccupancyMaxActiveBlocksPerMultiprocessor(&per_cu, (const void*)mk_fwd, NWAVES * 64, LDS_BYTES) != hipSuccess || per_cu < 1) { fprintf(stderr, "kernel_launch: occupancy query reports %d workgroups per CU\n", per_cu); }
        (void)hipGetLastError();
        grid = cus;
        if (grid < 40) { fprintf(stderr, "kernel_launch: needs >= 40 CUs\n"); grid = -1; return; }
    }
    if (grid < 0) return;
    (void)hipMemsetAsync((char*)d_ws + WS_CTL, 0, CTL_ZERO_BYTES, stream);
#ifdef DBG_ZERO_OUT
    (void)hipMemsetAsync(d_out, 0, (size_t)DBG_ZERO_OUT * 4, stream);
#endif
    Args a{};
    for (int i = 0; i < 18; ++i) a.in[i] = (const float*)d_in[i];
    a.out = (float*)d_out; a.ws = (unsigned char*)d_ws;
#if MK_N_LAUNCHES == 1
    a.ph_lo = 0; a.ph_hi = NPHASE;
    hipLaunchKernelGGL(mk_fwd, dim3(grid), dim3(NWAVES * 64), LDS_BYTES, stream, a);
#else
#ifndef DBG_MAXPH
#define DBG_MAXPH NPHASE
#endif
    for (int p = 0; p < DBG_MAXPH; ++p) { a.ph_lo = p; a.ph_hi = p + 1; hipLaunchKernelGGL(mk_fwd, dim3(grid), dim3(NWAVES * 64), LDS_BYTES, stream, a);
#ifdef DBG_DUP
        if (p == DBG_DUP) { a.flags = 1 | (DBG_DUPMASK << 8); hipLaunchKernelGGL(mk_fwd, dim3(grid), dim3(NWAVES * 64), LDS_BYTES, stream, a); a.flags = 0; }
#endif
    }
#endif
}
```
